# Optimizing an MI355X kernel written in HIP

```python
import jax, jax.numpy as jnp
from jax import lax
import numpy as np

D_MODEL = 1024
BATCH = 4
SEQ = 4096
DEPTH = 2

CHUNK = 64
EPS = 1e-6
HEAD_DV = 64
RWKV_WIDTH = D_MODEL // 2
RWKV_HEADS = RWKV_WIDTH // HEAD_DV
RWKV_N = HEAD_DV
RWKV_DECAY_LORA = 64
RWKV_AAA_LORA = 64
RWKV_MV_LORA = 32
RWKV_GATE_LORA = 128
RWKV_GN_EPS = 64e-5
GLA_WIDTH = D_MODEL // 4
GLA_HEADS = GLA_WIDTH // HEAD_DV
GLA_DK = HEAD_DV // 2
GLA_GATE_LORA = 16
GLA_GATE_TAU = 16.0
RET_WIDTH = D_MODEL - RWKV_WIDTH - GLA_WIDTH
RET_HEADS = RET_WIDTH // HEAD_DV
RET_DK = HEAD_DV // 2
ROPE_BASE = 10000.0
MIX_WIDTH = RWKV_WIDTH + GLA_WIDTH + RET_WIDTH
IN_SIZES = (RWKV_WIDTH, RWKV_WIDTH, RWKV_WIDTH,
            GLA_HEADS * GLA_DK, GLA_HEADS * GLA_DK, GLA_WIDTH, GLA_WIDTH,
            RET_HEADS * RET_DK, RET_HEADS * RET_DK, RET_WIDTH, RET_WIDTH)
D_IN = sum(IN_SIZES)
D_FF = -(-8 * D_MODEL // (3 * 256)) * 256

kernel_name = 'hymba_rwkv7_gla_retnet_adaln_trunk'


def _token_shift(x):
    return jnp.pad(x, ((0, 0), (1, 0), (0, 0)))[:, :-1, :]


def _rmsnorm(x, g):
    x32 = x.astype(jnp.float32)
    y = x32 * lax.rsqrt(jnp.mean(x32 * x32, axis=-1, keepdims=True) + EPS)
    return (y * g.astype(jnp.float32)).astype(x.dtype)


def _head_layernorm(y, eps):
    mu = jnp.mean(y, axis=-1, keepdims=True)
    yc = y - mu
    return yc * lax.rsqrt(jnp.mean(yc * yc, axis=-1, keepdims=True) + eps)


def _rope_tables(seq):
    half = RET_DK // 2
    inv_freq = ROPE_BASE ** (-jnp.arange(half, dtype=jnp.float32) / half)
    ang = jnp.arange(seq, dtype=jnp.float32)[:, None] * inv_freq[None, :]
    return jnp.cos(ang), jnp.sin(ang)


def _rope(x, cos, sin):
    half = x.shape[-1] // 2
    x1, x2 = x[..., :half], x[..., half:]
    c, s = cos[None, :, None, :], sin[None, :, None, :]
    return jnp.concatenate([x1 * c - x2 * s, x2 * c + x1 * s], axis=-1)


def _rwkv7_mixer(h, r, k, v, v_first, mu_rkv, mu_x, w0, w1, w2, a0, a1, a2,
                 g1, g2, k_k, k_a, r_k, ln_g, ln_b, vres):
    f32 = jnp.float32
    h = h.astype(f32)
    B, S, _ = h.shape
    H, N = RWKV_HEADS, RWKV_N
    dh = _token_shift(h) - h
    xw = h + dh * mu_x[0]
    xa = h + dh * mu_x[1]
    xg = h + dh * mu_x[2]
    r = r + (_token_shift(r) - r) * mu_rkv[0]
    k = k + (_token_shift(k) - k) * mu_rkv[1]
    v = v + (_token_shift(v) - v) * mu_rkv[2]
    w = -jax.nn.softplus(-(w0 + jnp.tanh(xw @ w1) @ w2)) - 0.5
    decay = jnp.exp(-jnp.exp(w))
    a = jax.nn.sigmoid(a0 + (xa @ a1) @ a2)
    g = jax.nn.sigmoid(xg @ g1) @ g2
    kk = (k * k_k).reshape(B, S, H, N)
    kk = kk / jnp.maximum(jnp.sqrt(jnp.sum(kk * kk, axis=-1, keepdims=True)), 1e-12)
    k = k * (1.0 + (a - 1.0) * k_a)
    if vres is not None:
        mu_v, v0, v1, v2 = vres
        xv = h + dh * mu_v
        v = v + (v_first - v) * jax.nn.sigmoid(v0 + (xv @ v1) @ v2)

    def to_tm(t):
        return jnp.moveaxis(t.reshape(B, S, H, N), 1, 0)

    xs = (to_tm(r), to_tm(decay), to_tm(k), to_tm(v), jnp.moveaxis(kk, 1, 0), to_tm(a))

    def step(state, inp):
        r_t, w_t, k_t, v_t, kk_t, a_t = inp
        s_kk = jnp.einsum('bhvk,bhk->bhv', state, kk_t)
        state = (state * w_t[:, :, None, :]
                 - s_kk[..., None] * (kk_t * a_t)[:, :, None, :]
                 + v_t[..., None] * k_t[:, :, None, :])
        return state, jnp.einsum('bhvk,bhk->bhv', state, r_t)

    _, y = lax.scan(step, jnp.zeros((B, H, N, N), f32), xs)
    y = jnp.moveaxis(y, 0, 1)
    y = _head_layernorm(y, RWKV_GN_EPS).reshape(B, S, H * N) * ln_g + ln_b
    rh, kh, vh = (t.reshape(B, S, H, N) for t in (r, k, v))
    bonus = jnp.sum(rh * kh * r_k, axis=-1, keepdims=True) * vh
    return (y + bonus.reshape(B, S, H * N)) * g, v


def _gla_mixer(h, q, k, v, gate, a1, a2, ab, ln_g):
    f32 = jnp.float32
    h = h.astype(f32)
    B, S, _ = h.shape
    NC, H, DK, DV = S // CHUNK, GLA_HEADS, GLA_DK, HEAD_DV
    log_a = jax.nn.log_sigmoid((h @ a1) @ a2 + ab) / GLA_GATE_TAU

    def chunked(t, d):
        return t.reshape(B, NC, CHUNK, H, d).transpose(1, 0, 3, 2, 4)

    qc = chunked(q * DK ** -0.5, DK)
    kc = chunked(k, DK)
    vc = chunked(v, DV)
    bc = jnp.cumsum(chunked(log_a, DK), axis=3)
    b_end = bc[:, :, :, -1:, :]
    kv = jnp.einsum('nbhcd,nbhce->nbhde', kc * jnp.exp(b_end - bc), vc)

    def step(state, inp):
        kv_c, dec_c = inp
        return state * dec_c[..., None] + kv_c, state

    _, s_prev = lax.scan(step, jnp.zeros((B, H, DK, DV), f32), (kv, jnp.exp(b_end[:, :, :, 0, :])))
    inter = jnp.einsum('nbhcd,nbhde->nbhce', qc * jnp.exp(bc), s_prev)

    def intra(blk):
        q_, k_, v_, b_ = blk
        dec = jnp.exp(-jnp.abs(b_[:, :, :, None, :] - b_[:, :, None, :, :]))
        att = jnp.sum(q_[:, :, :, None, :] * k_[:, :, None, :, :] * dec, axis=-1)
        return jnp.einsum('bhnm,bhme->bhne', att, v_)

    o = inter + lax.map(intra, (qc, kc, vc, bc))
    o = o.transpose(1, 0, 3, 2, 4).reshape(B, S, H, DV)
    o = o * lax.rsqrt(jnp.mean(o * o, axis=-1, keepdims=True) + EPS) * ln_g
    return o.reshape(B, S, H * DV) * jax.nn.silu(gate)


def _retention_mixer(q, k, v, gate, cos, sin):
    f32 = jnp.float32
    B, S, _ = q.shape
    NC, H, DK, DV = S // CHUNK, RET_HEADS, RET_DK, HEAD_DV
    qh = _rope(q.reshape(B, S, H, DK), cos, sin) * DK ** -0.5
    kh = _rope(k.reshape(B, S, H, DK), cos, sin)
    log_gamma = jnp.log1p(-(2.0 ** (-5.0 - jnp.arange(H, dtype=f32))))
    pos = jnp.arange(CHUNK, dtype=f32)
    intra_dec = jnp.exp(log_gamma[:, None, None] * jnp.abs(pos[:, None] - pos[None, :]))
    k_dec = jnp.exp(log_gamma[None, :] * (CHUNK - 1.0 - pos)[:, None])
    q_dec = jnp.exp(log_gamma[None, :] * (pos + 1.0)[:, None])
    chunk_dec = jnp.exp(log_gamma * CHUNK)
    qc = qh.reshape(B, NC, CHUNK, H, DK)
    kc = kh.reshape(B, NC, CHUNK, H, DK)
    vc = v.reshape(B, NC, CHUNK, H, DV)
    scores = jnp.einsum('bnchd,bnmhd->bnhcm', qc, kc) * intra_dec
    intra = jnp.einsum('bnhcm,bnmhe->bnche', scores, vc)
    kv = jnp.einsum('bnmhd,bnmhe->nbhde', kc * k_dec[:, :, None], vc)

    def step(state, kv_c):
        return state * chunk_dec[:, None, None] + kv_c, state

    _, s_prev = lax.scan(step, jnp.zeros((B, H, DK, DV), f32), kv)
    inter = jnp.einsum('bnchd,nbhde->bnche', qc * q_dec[:, :, None], s_prev)
    o = _head_layernorm((intra + inter).reshape(B, S, H, DV), EPS)
    return o.reshape(B, S, H * DV) * jax.nn.silu(gate)


def setup_inputs(seed: int = 0) -> dict:
    key = jax.random.key(seed)
    ks = iter(jax.random.split(key, 48))
    f32 = jnp.float32

    def nrm(shape, scale):
        return jax.random.normal(next(ks), shape, f32) * scale

    def unif(shape, lo, hi):
        return jax.random.uniform(next(ks), shape, f32, lo, hi)

    L, D, RW = DEPTH, D_MODEL, RWKV_WIDTH
    return {
        'x': nrm((BATCH, SEQ, D), 1.0),
        'c': nrm((BATCH, D), 1.0),
        'ada_w': nrm((L, D, 6 * D), 0.02),
        'ada_b': nrm((L, 6 * D), 0.01),
        'norm1_g': 1.0 + nrm((L, D), 0.02),
        'norm2_g': 1.0 + nrm((L, D), 0.02),
        'w_in': nrm((L, D, D_IN), D ** -0.5),
        'w_out': nrm((L, MIX_WIDTH, D), MIX_WIDTH ** -0.5),
        'rk_mu_rkv': unif((L, 3, RW), 0.0, 1.0),
        'rk_mu_x': unif((L, 3, D), 0.0, 1.0),
        'rk_w0': unif((L, RW), -6.0, 1.0),
        'rk_w1': nrm((L, D, RWKV_DECAY_LORA), D ** -0.5),
        'rk_w2': nrm((L, RWKV_DECAY_LORA, RW), 0.1),
        'rk_a0': nrm((L, RW), 0.5),
        'rk_a1': nrm((L, D, RWKV_AAA_LORA), D ** -0.5),
        'rk_a2': nrm((L, RWKV_AAA_LORA, RW), 0.1),
        'rk_g1': nrm((L, D, RWKV_GATE_LORA), D ** -0.5),
        'rk_g2': nrm((L, RWKV_GATE_LORA, RW), RWKV_GATE_LORA ** -0.5),
        'rk_k_k': 0.85 + nrm((L, RW), 0.05),
        'rk_k_a': 1.0 + nrm((L, RW), 0.05),
        'rk_r_k': nrm((L, RWKV_HEADS, RWKV_N), 0.1),
        'rk_ln_g': 1.0 + nrm((L, RW), 0.02),
        'rk_ln_b': nrm((L, RW), 0.01),
        'rk_mu_v': unif((L - 1, D), 0.0, 1.0),
        'rk_v0': nrm((L - 1, RW), 0.5),
        'rk_v1': nrm((L - 1, D, RWKV_MV_LORA), D ** -0.5),
        'rk_v2': nrm((L - 1, RWKV_MV_LORA, RW), 0.1),
        'gla_a1': nrm((L, D, GLA_GATE_LORA), D ** -0.5),
        'gla_a2': nrm((L, GLA_GATE_LORA, GLA_HEADS * GLA_DK), GLA_GATE_LORA ** -0.5),
        'gla_ab': nrm((L, GLA_HEADS * GLA_DK), 0.1),
        'gla_ln_g': 1.0 + nrm((L, HEAD_DV), 0.02),
        'ffn_w_gate': nrm((L, D, D_FF), D ** -0.5),
        'ffn_w_up': nrm((L, D, D_FF), D ** -0.5),
        'ffn_w_down': nrm((L, D_FF, D), D_FF ** -0.5),
        'norm_f_g': 1.0 + nrm((D,), 0.02),
    }


def reference(x, c, ada_w, ada_b, norm1_g, norm2_g, w_in, w_out,
              rk_mu_rkv, rk_mu_x, rk_w0, rk_w1, rk_w2, rk_a0, rk_a1, rk_a2,
              rk_g1, rk_g2, rk_k_k, rk_k_a, rk_r_k, rk_ln_g, rk_ln_b,
              rk_mu_v, rk_v0, rk_v1, rk_v2,
              gla_a1, gla_a2, gla_ab, gla_ln_g,
              ffn_w_gate, ffn_w_up, ffn_w_down, norm_f_g):
    f32 = jnp.float32
    S = x.shape[1]
    cos, sin = _rope_tables(S)
    splits = np.cumsum(IN_SIZES)[:-1].tolist()
    cond = jax.nn.silu(c)
    v_first = None
    for l in range(DEPTH):
        mod = (cond @ ada_w[l] + ada_b[l])[:, None, :]
        sh1, sc1, gt1, sh2, sc2, gt2 = jnp.split(mod, 6, axis=-1)
        h = _rmsnorm(x, norm1_g[l]) * (1.0 + sc1) + sh1
        (rw_r, rw_k, rw_v, gl_q, gl_k, gl_v, gl_g,
         rt_q, rt_k, rt_v, rt_g) = jnp.split((h @ w_in[l]).astype(f32), splits, axis=-1)
        vres = None if l == 0 else (rk_mu_v[l - 1], rk_v0[l - 1], rk_v1[l - 1], rk_v2[l - 1])
        y_a, v_l = _rwkv7_mixer(h, rw_r, rw_k, rw_v, v_first, rk_mu_rkv[l], rk_mu_x[l],
                                rk_w0[l], rk_w1[l], rk_w2[l], rk_a0[l], rk_a1[l], rk_a2[l],
                                rk_g1[l], rk_g2[l], rk_k_k[l], rk_k_a[l], rk_r_k[l],
                                rk_ln_g[l], rk_ln_b[l], vres)
        if l == 0:
            v_first = v_l
        y_b = _gla_mixer(h, gl_q, gl_k, gl_v, gl_g, gla_a1[l], gla_a2[l], gla_ab[l], gla_ln_g[l])
        y_c = _retention_mixer(rt_q, rt_k, rt_v, rt_g, cos, sin)
        y = jnp.concatenate([y_a, y_b, y_c], axis=-1).astype(x.dtype) @ w_out[l]
        x = x + gt1 * y
        h = _rmsnorm(x, norm2_g[l]) * (1.0 + sc2) + sh2
        x = x + gt2 * ((jax.nn.silu(h @ ffn_w_gate[l]) * (h @ ffn_w_up[l])) @ ffn_w_down[l])
    return _rmsnorm(x, norm_f_g)
```

```cpp
#include <hip/hip_runtime.h>
#include <hip/hip_cooperative_groups.h>
#include <cstdio>
#include <cstdint>
namespace cg = cooperative_groups;
#ifndef MK_MULTI
#define MK_MULTI 0
#endif
__device__ __forceinline__ int ltid() { int t = threadIdx.x; asm volatile("" : "+v"(t)); return t; }
__device__ __forceinline__ int lbid() { int b = blockIdx.x; asm volatile("" : "+s"(b)); return b; }
namespace pg8 {
#define PG8_LAS __attribute__((address_space(3)))
typedef unsigned short bf16_t;
typedef short bf16x8 __attribute__((ext_vector_type(8)));
typedef float f32x4 __attribute__((ext_vector_type(4)));
typedef unsigned u32x4 __attribute__((ext_vector_type(4)));
constexpr int BM = 256, BK = 64, HALF = 128, HTB = HALF * BK * 2  , STAGE_BYTES = 8 * HTB, NXCD = 8, WGM = 8;

__host__ __device__ __forceinline__ int lds_byte(int r, int c) { const int st = (r >> 4) * 2 + (c >> 5), rr = r & 15, cc = c & 31, ob = rr * 64 + cc * 2; return st * 1024 + (ob ^ (((ob >> 9) & 1) << 5)); }
__host__ __device__ __forceinline__ void stage_rc(int b, int& R, int& C) { const int st = b / 1024, sb = b % 1024, swz = sb ^ (((sb >> 9) & 1) << 5); R = (st >> 1) * 16 + swz / 64; C = (st & 1) * 32 + (swz % 64) / 2; }
__host__ __device__ __forceinline__ int perm32(int rho) { const int n = rho >> 4, i = rho & 15; return 8 * (i >> 2) + 4 * n + (i & 3); }

struct Unit { int pm, pn; };
struct Gemm { const bf16_t* A; const bf16_t* Bt; int M, N, K, lda; };

struct StaticOrder {
    int nM, nN, nwg, G, c;
    __host__ __device__ void init(int M, int N, int G_, int c_) { nM = M / BM; nN = N / BM; nwg = nM * nN; G = G_; c = c_; }
    __host__ __device__ bool next(int i, Unit& u) const {
        const long L = (long)i * G + c; if (L >= nwg) return false;
        int wgid = (int)L; { const int q = nwg / NXCD, r = nwg % NXCD, xcd = wgid % NXCD, off = wgid / NXCD; wgid = (xcd < r ? xcd * (q + 1) : r * (q + 1) + (xcd - r) * q) + off; }
        const int nig = WGM * nN, gid = wgid / nig, fm = gid * WGM, gsz = (nM - fm) < WGM ? (nM - fm) : WGM;
        u.pm = fm + ((wgid % nig) % gsz); u.pn = (wgid % nig) / gsz; return true;
    }
    __device__ __forceinline__ void a_ready(const Unit&) const {}
    __device__ __forceinline__ void done(const Unit&) const {}
};

__device__ __forceinline__ unsigned cvt_pk_bf16(float lo, float hi) { unsigned r; asm volatile("v_cvt_pk_bf16_f32 %0, %1, %2" : "=v"(r) : "v"(lo), "v"(hi)); return r; }
typedef float f32x2 __attribute__((ext_vector_type(2)));
__device__ __forceinline__ f32x2 gelu_pk(f32x2 v) {
    const f32x2 av = __builtin_elementwise_abs(v), d = av * 0.2316418882f + 1.0f;
    f32x2 t; t.x = __builtin_amdgcn_rcpf(d.x); t.y = __builtin_amdgcn_rcpf(d.y);
    f32x2 q = t * 0.5307027145f + (-0.7265760135f); q = q * t + 0.7107068705f; q = q * t + (-0.142248368f); q = q * t + 0.127414796f; q = q * t;
    const f32x2 s = (v * v) * (-0.72134752044f);
    f32x2 e; e.x = __builtin_amdgcn_exp2f(s.x); e.y = __builtin_amdgcn_exp2f(s.y);
    const f32x2 m = v * (q * e), r = v - m;
    f32x2 o; o.x = v.x < 0.f ? m.x : r.x; o.y = v.y < 0.f ? m.y : r.y; return o;
}

template <int ACT  > struct EpiBf16 {
    static constexpr bool PERM = true, AFTER_DRAIN = false; static_assert(ACT == 0 || ACT == 1, "EpiBf16: ACT is 0 (none) or 1 (gelu_pk)");
    bf16_t* O; int ldc; const float* bias; int split_cols; size_t split_stride; float scale0;
    __device__ __forceinline__ void operator()(const f32x4 (&acc)[2][2][4][2], const Unit& u, int wr, int wc, int fr, int fq) const {
        const int row0 = u.pm * BM + wr * 64 + fr; int colt = u.pn * BM; bf16_t* base = O;
        float sc = 1.f; if (split_cols) { const int t = colt / split_cols; base += (size_t)t * split_stride; colt -= t * split_cols; if (t == 0) sc = scale0; }
        const int col0 = colt + wc * 32 + 8 * fq, bcol0 = u.pn * BM + wc * 32 + 8 * fq;
        f32x4 bv[2][2];
#pragma unroll
        for (int bj = 0; bj < 2; ++bj)
#pragma unroll
            for (int n = 0; n < 2; ++n) bv[bj][n] = bias ? *(const f32x4*)(bias + bcol0 + bj * HALF + 4 * n) : (f32x4){0.f, 0.f, 0.f, 0.f};
#pragma unroll
        for (int ai = 0; ai < 2; ++ai)
#pragma unroll
            for (int m = 0; m < 4; ++m) { bf16_t* rowp = base + (size_t)(row0 + ai * HALF + m * 16) * ldc + col0;
#pragma unroll
                for (int bj = 0; bj < 2; ++bj) { f32x4 v0 = acc[ai][bj][m][0] + bv[bj][0], v1 = acc[ai][bj][m][1] + bv[bj][1];
                    if (ACT == 1) { f32x2 a = gelu_pk((f32x2){v0[0], v0[1]}), b = gelu_pk((f32x2){v0[2], v0[3]}), c = gelu_pk((f32x2){v1[0], v1[1]}), d = gelu_pk((f32x2){v1[2], v1[3]});
                        v0 = (f32x4){a.x, a.y, b.x, b.y}; v1 = (f32x4){c.x, c.y, d.x, d.y}; }
                    v0 = v0 * sc; v1 = v1 * sc; u32x4 w; w.x = cvt_pk_bf16(v0[0], v0[1]); w.y = cvt_pk_bf16(v0[2], v0[3]); w.z = cvt_pk_bf16(v1[0], v1[1]); w.w = cvt_pk_bf16(v1[2], v1[3]);
                    *(u32x4*)(rowp + bj * HALF) = w; } }
    }
};
template <class Epi, class Sched, bool ALIGN_EPI = false, bool SP2 = false>
__device__ __forceinline__ void gemm_phase(PG8_LAS unsigned char* lds, const Gemm g, const Sched& S, const Epi& E) {
    const int tid = ltid(), wid = __builtin_amdgcn_readfirstlane(tid >> 6), lane = tid & 63, wr = wid >> 2, wc = wid & 3, fr = lane & 15, fq = lane >> 4;
    const int K = g.K, nt = K / BK;
    unsigned voffA[2], voffB[2];
#pragma unroll
    for (int i = 0; i < 2; ++i) { int R, C; stage_rc(tid * 16 + i * 8192, R, C); const int Rb = Epi::PERM ? ((R & ~31) + perm32(R & 31)) : R;
        voffA[i] = (unsigned)(R * g.lda + C) * 2u; voffB[i] = (unsigned)(Rb * K + C) * 2u; }
    const size_t kstep = (size_t)(BK * 2);
    const size_t hstep = (size_t)HALF * K * 2;
    const size_t tstep = 2 * hstep; const size_t hstepA = (size_t)HALF * g.lda * 2, tstepA = 2 * hstepA;
    const unsigned ldsw = (unsigned)wid * 1024u;
    const int aoff = lds_byte(wr * 64 + fr, fq * 8), boff = lds_byte(wc * 32 + fr, fq * 8);
#define PG8_SA(b, h) (((b) * 2 + (h)) * HTB)
#define PG8_SB(b, h) ((4 + (b) * 2 + (h)) * HTB)
#define PG8_STAGE(bufoff, gbase, voff) do { _Pragma("unroll") for (int _i = 0; _i < 2; ++_i) \
        __builtin_amdgcn_global_load_lds((const unsigned*)((const char*)(gbase) + (voff)[_i]), (PG8_LAS unsigned*)(lds + (bufoff) + ldsw + _i * 8192), 16, 0, 0); } while (0)
#define PG8_LDA(dst, b, h) do { _Pragma("unroll") for (int m = 0; m < 4; ++m) _Pragma("unroll") for (int k = 0; k < 2; ++k) dst[m][k] = *(const PG8_LAS bf16x8*)(lds + PG8_SA(b, h) + aoff + m * 2048 + k * 1024); } while (0)
#define PG8_LDB(dst, b, h) do { _Pragma("unroll") for (int n = 0; n < 2; ++n) _Pragma("unroll") for (int k = 0; k < 2; ++k) dst[n][k] = *(const PG8_LAS bf16x8*)(lds + PG8_SB(b, h) + boff + n * 2048 + k * 1024); } while (0)
#define PG8_MMA(ai, bj, At, Bt) do { __builtin_amdgcn_s_setprio(1); _Pragma("unroll") for (int m = 0; m < 4; ++m) _Pragma("unroll") for (int n = 0; n < 2; ++n) _Pragma("unroll") for (int k = 0; k < 2; ++k) \
        acc[ai][bj][m][n] = __builtin_amdgcn_mfma_f32_16x16x32_bf16(Bt[n][k], At[m][k], acc[ai][bj][m][n], 0, 0, 0); __builtin_amdgcn_s_setprio(0); } while (0)
#define PG8_WAIT_V(n) asm volatile("s_waitcnt vmcnt(" #n ")" ::: "memory")
#define PG8_WAIT_L(n) asm volatile("s_waitcnt lgkmcnt(" #n ")" ::: "memory")
#define PG8_BAR __builtin_amdgcn_s_barrier()
#define PG8_SCHED __builtin_amdgcn_sched_barrier(0)
    Unit cur, nxt; int ui = 0;
    if (!S.next(0, cur)) return;
    f32x4 acc[2][2][4][2];
#pragma unroll
    for (int a = 0; a < 2; ++a)
#pragma unroll
        for (int b = 0; b < 2; ++b)
#pragma unroll
            for (int m = 0; m < 4; ++m)
#pragma unroll
                for (int n = 0; n < 2; ++n) acc[a][b][m][n] = (f32x4){0.f, 0.f, 0.f, 0.f};
    bf16x8 At[4][2], B0[2][2], B1[2][2];
    const char* cA = (const char*)g.A + (size_t)cur.pm * tstepA; const char* cB = (const char*)g.Bt + (size_t)cur.pn * tstep;
    S.a_ready(cur);
    if constexpr (SP2) {
        PG8_STAGE(PG8_SB(0, 0), cB, voffB); PG8_STAGE(PG8_SB(0, 1), cB + hstep, voffB); PG8_STAGE(PG8_SA(0, 0), cA, voffA); PG8_STAGE(PG8_SA(0, 1), cA + hstepA, voffA);
        if (wr == 1) PG8_BAR;
        PG8_WAIT_V(2); PG8_BAR;
        PG8_STAGE(PG8_SB(1, 0), cB + kstep, voffB); PG8_STAGE(PG8_SA(1, 0), cA + kstep, voffA); PG8_STAGE(PG8_SB(1, 1), cB + hstep + kstep, voffB);
        PG8_WAIT_V(6); PG8_BAR;
    } else {
        PG8_STAGE(PG8_SB(0, 0), cB, voffB); PG8_STAGE(PG8_SA(0, 0), cA, voffA); PG8_STAGE(PG8_SB(0, 1), cB + hstep, voffB); PG8_STAGE(PG8_SA(0, 1), cA + hstepA, voffA);
        if (wr == 1) PG8_BAR;
        PG8_WAIT_V(4); PG8_BAR;
        PG8_STAGE(PG8_SB(1, 0), cB + kstep, voffB); PG8_STAGE(PG8_SA(1, 0), cA + kstep, voffA); PG8_STAGE(PG8_SB(1, 1), cB + hstep + kstep, voffB);
        PG8_WAIT_V(6); PG8_BAR;
    }
    for (;;) {
        const bool has_next = S.next(ui + 1, nxt);
        const char* nA = has_next ? (const char*)g.A + (size_t)nxt.pm * tstepA : cA; const char* nB = has_next ? (const char*)g.Bt + (size_t)nxt.pn * tstep : cB;
        _Pragma("unroll 1") for (int t = 0; t < nt; t += 2) {
            const bool last = (t == nt - 2);
            const char* a1 = cA + (size_t)(t + 1) * kstep;
            const char* a2 = last ? nA : cA + (size_t)(t + 2) * kstep; const char* b2 = last ? nB : cB + (size_t)(t + 2) * kstep;
            const char* a3 = a2 + kstep; const char* b3 = b2 + kstep;
            if (last && has_next) S.a_ready(nxt);
            if constexpr (SP2) {
            PG8_LDB(B0, 0, 0); PG8_LDB(B1, 0, 1); PG8_SCHED; PG8_LDA(At, 0, 0); PG8_STAGE(PG8_SA(1, 1), a1 + hstepA, voffA);
            PG8_WAIT_V(8); PG8_WAIT_L(0); PG8_BAR; PG8_MMA(0, 0, At, B0); PG8_MMA(0, 1, At, B1); PG8_BAR; PG8_SCHED;
            PG8_LDA(At, 0, 1); PG8_STAGE(PG8_SB(0, 0), b2, voffB); PG8_STAGE(PG8_SB(0, 1), b2 + hstep, voffB); PG8_STAGE(PG8_SA(0, 0), a2, voffA);
            PG8_WAIT_V(8); PG8_WAIT_L(0); PG8_BAR; PG8_MMA(1, 0, At, B0); PG8_MMA(1, 1, At, B1); PG8_BAR; PG8_SCHED;
            PG8_LDB(B0, 1, 0); PG8_LDB(B1, 1, 1); PG8_SCHED; PG8_LDA(At, 1, 0); PG8_STAGE(PG8_SA(0, 1), a2 + hstepA, voffA);
            PG8_WAIT_V(8); PG8_WAIT_L(0); PG8_BAR; PG8_MMA(0, 0, At, B0); PG8_MMA(0, 1, At, B1); PG8_BAR; PG8_SCHED;
            PG8_LDA(At, 1, 1); PG8_STAGE(PG8_SB(1, 0), b3, voffB); PG8_STAGE(PG8_SB(1, 1), b3 + hstep, voffB); PG8_STAGE(PG8_SA(1, 0), a3, voffA);
            PG8_WAIT_V(8); PG8_WAIT_L(0); PG8_BAR; PG8_MMA(1, 0, At, B0); PG8_MMA(1, 1, At, B1); PG8_BAR; PG8_SCHED;
            } else {
            PG8_LDB(B0, 0, 0); PG8_SCHED; PG8_LDA(At, 0, 0); PG8_STAGE(PG8_SA(1, 1), a1 + hstepA, voffA);
            PG8_WAIT_L(8); PG8_BAR; PG8_WAIT_L(0); PG8_MMA(0, 0, At, B0); PG8_BAR; PG8_SCHED;
            PG8_LDB(B1, 0, 1); PG8_STAGE(PG8_SB(0, 0), b2, voffB);
            PG8_BAR; PG8_WAIT_L(0); PG8_MMA(0, 1, At, B1); PG8_BAR;
            PG8_LDA(At, 0, 1); PG8_STAGE(PG8_SA(0, 0), a2, voffA);
            PG8_BAR; PG8_WAIT_L(0); PG8_MMA(1, 0, At, B0); PG8_BAR; PG8_SCHED;
            PG8_STAGE(PG8_SB(0, 1), b2 + hstep, voffB);
            PG8_WAIT_V(6); PG8_BAR; PG8_MMA(1, 1, At, B1); PG8_BAR;
            PG8_LDB(B0, 1, 0); PG8_SCHED; PG8_LDA(At, 1, 0); PG8_STAGE(PG8_SA(0, 1), a2 + hstepA, voffA);
            PG8_WAIT_L(8); PG8_BAR; PG8_WAIT_L(0); PG8_MMA(0, 0, At, B0); PG8_BAR; PG8_SCHED;
            PG8_LDB(B1, 1, 1); PG8_STAGE(PG8_SB(1, 0), b3, voffB);
            PG8_BAR; PG8_WAIT_L(0); PG8_MMA(0, 1, At, B1); PG8_BAR;
            PG8_LDA(At, 1, 1); PG8_STAGE(PG8_SA(1, 0), a3, voffA);
            PG8_BAR; PG8_WAIT_L(0); PG8_MMA(1, 0, At, B0); PG8_BAR; PG8_SCHED;
            PG8_STAGE(PG8_SB(1, 1), b3 + hstep, voffB);
            PG8_WAIT_V(6); PG8_BAR; PG8_MMA(1, 1, At, B1); PG8_BAR;
            }
        }
        if constexpr (ALIGN_EPI) { if (wr == 0) PG8_BAR; }
        if constexpr (!Epi::AFTER_DRAIN) { E(acc, cur, wr, wc, fr, fq); S.done(cur); }
        if (!has_next) break;
#pragma unroll
        for (int a = 0; a < 2; ++a)
#pragma unroll
            for (int b = 0; b < 2; ++b)
#pragma unroll
                for (int m = 0; m < 4; ++m)
#pragma unroll
                    for (int n = 0; n < 2; ++n) acc[a][b][m][n] = (f32x4){0.f, 0.f, 0.f, 0.f};
        cur = nxt; cA = nA; cB = nB; ++ui;
        if constexpr (ALIGN_EPI) { if (wr == 1) PG8_BAR; }
    }
    PG8_WAIT_V(0);
    if constexpr (!ALIGN_EPI) { if (wr == 0) PG8_BAR; }
    PG8_BAR;
    if constexpr (Epi::AFTER_DRAIN) { E.fused(acc, cur, wr, wc, fr, fq, lds, wid, lane); S.done(cur); }
#undef PG8_SA
#undef PG8_SB
#undef PG8_STAGE
#undef PG8_LDA
#undef PG8_LDB
#undef PG8_MMA
#undef PG8_WAIT_V
#undef PG8_WAIT_L
#undef PG8_BAR
#undef PG8_SCHED
}
}

#define LAS __attribute__((address_space(3)))
typedef unsigned short bf16_t;
typedef float f32x4 __attribute__((ext_vector_type(4)));
typedef LAS float lfloat;

constexpr int NB = 4, SEQ = 4096, DM = 1024, MT = NB * SEQ, NL = 2;
constexpr int NIN = 3840, K2 = 384, N2 = 2304, DFF = 2816, NGU = 5632;
#ifndef EXTRA_SYNCS
#define EXTRA_SYNCS 0
#endif
#ifndef SCAN_TWICE
#define SCAN_TWICE 0
#endif
#ifndef XTRA_LDS
#define XTRA_LDS 0
#endif
#ifndef DUPMASK
#define DUPMASK 0
#endif
#ifndef PHMASK
#define PHMASK 0xfff
#endif
constexpr int NPH = 12;
constexpr size_t MiB = 1u << 20;
constexpr size_t OFF_MOD = 0, OFF_DEC = 1 * MiB, OFF_W = 2 * MiB;
constexpr size_t OFF_WIN = OFF_W, OFF_WO = OFF_WIN + (size_t)NIN * DM * 2, OFF_WGU = OFF_WO + (size_t)DM * DM * 2,
                 OFF_WD = OFF_WGU + (size_t)NGU * DM * 2, OFF_W2L = OFF_WD + (size_t)DM * DFF * 2, OFF_WEND = OFF_W2L + (size_t)N2 * K2 * 2;
constexpr size_t OFF_VF = 30 * MiB, OFF_XN = 46 * MiB, OFF_KV = OFF_XN, OFF_YS = OFF_XN + 16 * MiB;
constexpr size_t OFF_ZR = 78 * MiB, OFF_ZG = 126 * MiB, OFF_HFF = OFF_ZR, OFF_PRE = 174 * MiB, OFF_ZX = OFF_PRE, OFF_BND = 246 * MiB, OFF_BND0 = 249 * MiB, OFF_C12 = 250 * MiB, OFF_END = 251 * MiB;
static_assert(OFF_WEND <= OFF_VF, "weights fit");

struct Args { const float* in[35]; float* out; unsigned char* ws; int ph_lo, ph_hi, coop, pad; };
typedef const __attribute__((address_space(4))) Args CArgs;
__device__ __forceinline__ CArgs* launder_args(CArgs* p) { asm volatile("" : "+s"(p)); return p; }

__device__ __forceinline__ float bf2f(unsigned u16) { return __uint_as_float(u16 << 16); }
__device__ __forceinline__ f32x4 unpack4(uint2 u) { return (f32x4){__uint_as_float(u.x << 16), __uint_as_float(u.x & 0xffff0000u), __uint_as_float(u.y << 16), __uint_as_float(u.y & 0xffff0000u)}; }
typedef unsigned u32x2 __attribute__((ext_vector_type(2)));
__device__ __forceinline__ f32x4 unpack4(u32x2 u) { return (f32x4){__uint_as_float(u[0] << 16), __uint_as_float(u[0] & 0xffff0000u), __uint_as_float(u[1] << 16), __uint_as_float(u[1] & 0xffff0000u)}; }
__device__ __forceinline__ uint2 pack4(f32x4 v) { uint2 r; r.x = pg8::cvt_pk_bf16(v[0], v[1]); r.y = pg8::cvt_pk_bf16(v[2], v[3]); return r; }
__device__ __forceinline__ unsigned short f2bf1(float v) { return (unsigned short)(pg8::cvt_pk_bf16(v, 0.f) & 0xffffu); }
__device__ __forceinline__ float sigmoidf_(float x) { return __builtin_amdgcn_rcpf(1.f + __expf(-x)); }
__device__ __forceinline__ float siluf_(float x) { return x * sigmoidf_(x); }
__device__ __forceinline__ float tanhf_(float x) { return 1.f - 2.f * __builtin_amdgcn_rcpf(__expf(2.f * x) + 1.f); }
__device__ __forceinline__ float softplusf_(float z) { return fmaxf(z, 0.f) + __logf(1.f + __expf(-fabsf(z))); }
__device__ __forceinline__ float row_allreduce16(float v) {
    v += __int_as_float(__builtin_amdgcn_update_dpp(0, __float_as_int(v), 0x128, 0xf, 0xf, false));
    v += __int_as_float(__builtin_amdgcn_update_dpp(0, __float_as_int(v), 0x124, 0xf, 0xf, false));
    v += __int_as_float(__builtin_amdgcn_update_dpp(0, __float_as_int(v), 0x122, 0xf, 0xf, false));
    v += __int_as_float(__builtin_amdgcn_update_dpp(0, __float_as_int(v), 0x121, 0xf, 0xf, false));
    return v;
}
__device__ __forceinline__ float row_allreduce32(float v) {
    v = row_allreduce16(v);
    const auto rr = __builtin_amdgcn_permlane32_swap(__float_as_uint(v), __float_as_uint(v), false, false);
    return __uint_as_float(rr[0]) + __uint_as_float(rr[1]);
}
__device__ __forceinline__ float wave_sum(float v) {
#pragma unroll
    for (int o = 1; o < 64; o <<= 1) v += __shfl_xor(v, o);
    return v;
}
#define LDS_BARRIER() do { asm volatile("s_waitcnt lgkmcnt(0)" ::: "memory"); __builtin_amdgcn_s_barrier(); asm volatile("" ::: "memory"); } while (0)
__device__ __forceinline__ float sum4(f32x4 v) { return (v[0] + v[1]) + (v[2] + v[3]); }

namespace pg8 {
struct EpiIn {
    static constexpr bool PERM = true, AFTER_DRAIN = false;
    bf16_t *ZR, *ZG, *ZX;
    __device__ __forceinline__ void operator()(const f32x4 (&acc)[2][2][4][2], const Unit& u, int wr, int wc, int fr, int fq) const {
        int colt = u.pn * BM; bf16_t* base; int ldc;
        if (colt < 1536) { base = ZR; ldc = 1536; } else if (colt < 3072) { base = ZG; ldc = 1536; colt -= 1536; } else { base = ZX; ldc = 768; colt -= 3072; }
        const int row0 = u.pm * BM + wr * 64 + fr, col0 = colt + wc * 32 + 8 * fq;
#pragma unroll
        for (int ai = 0; ai < 2; ++ai)
#pragma unroll
            for (int m = 0; m < 4; ++m) { bf16_t* rowp = base + (size_t)(row0 + ai * HALF + m * 16) * ldc + col0;
#pragma unroll
                for (int bj = 0; bj < 2; ++bj) { const f32x4 v0 = acc[ai][bj][m][0], v1 = acc[ai][bj][m][1];
                    u32x4 w; w.x = cvt_pk_bf16(v0[0], v0[1]); w.y = cvt_pk_bf16(v0[2], v0[3]); w.z = cvt_pk_bf16(v1[0], v1[1]); w.w = cvt_pk_bf16(v1[2], v1[3]);
                    *(u32x4*)(rowp + bj * HALF) = w; } }
    }
};
struct EpiPlain {
    static constexpr bool PERM = true, AFTER_DRAIN = false;
    bf16_t* O; int ldc;
    __device__ __forceinline__ void operator()(const f32x4 (&acc)[2][2][4][2], const Unit& u, int wr, int wc, int fr, int fq) const {
        const int row0 = u.pm * BM + wr * 64 + fr, col0 = u.pn * BM + wc * 32 + 8 * fq;
#pragma unroll
        for (int ai = 0; ai < 2; ++ai)
#pragma unroll
            for (int m = 0; m < 4; ++m) { bf16_t* rowp = O + (size_t)(row0 + ai * HALF + m * 16) * ldc + col0;
#pragma unroll
                for (int bj = 0; bj < 2; ++bj) { const f32x4 v0 = acc[ai][bj][m][0], v1 = acc[ai][bj][m][1];
                    u32x4 w; w.x = cvt_pk_bf16(v0[0], v0[1]); w.y = cvt_pk_bf16(v0[2], v0[3]); w.z = cvt_pk_bf16(v1[0], v1[1]); w.w = cvt_pk_bf16(v1[2], v1[3]);
                    *(u32x4*)(rowp + bj * HALF) = w; } }
    }
};
struct EpiRes {
    static constexpr bool PERM = true, AFTER_DRAIN = false;
    const float* xin; float* xout; const float* gate;
    __device__ __forceinline__ void operator()(const f32x4 (&acc)[2][2][4][2], const Unit& u, int wr, int wc, int fr, int fq) const {
        const int b = u.pm >> 4; const float* gp = gate + b * 6144;
        const int row0 = u.pm * BM + wr * 64 + fr, col0 = u.pn * BM + wc * 32 + 8 * fq;
        f32x4 gv[2][2];
#pragma unroll
        for (int bj = 0; bj < 2; ++bj)
#pragma unroll
            for (int n = 0; n < 2; ++n) gv[bj][n] = *(const f32x4*)(gp + col0 + bj * HALF + 4 * n);
#pragma unroll
        for (int ai = 0; ai < 2; ++ai)
#pragma unroll
            for (int m = 0; m < 4; ++m) { const size_t off = (size_t)(row0 + ai * HALF + m * 16) * 1024 + col0;
#pragma unroll
                for (int bj = 0; bj < 2; ++bj)
#pragma unroll
                    for (int n = 0; n < 2; ++n) { const f32x4 xi = *(const f32x4*)(xin + off + bj * HALF + 4 * n);
                        *(f32x4*)(xout + off + bj * HALF + 4 * n) = xi + gv[bj][n] * acc[ai][bj][m][n]; } }
    }
};
struct EpiSwiGLU {
    static constexpr bool PERM = true, AFTER_DRAIN = false;
    bf16_t* H;
    __device__ __forceinline__ void operator()(const f32x4 (&acc)[2][2][4][2], const Unit& u, int wr, int wc, int fr, int fq) const {
        const int row0 = u.pm * BM + wr * 64 + fr, col0 = u.pn * HALF + wc * 32 + 8 * fq;
#pragma unroll
        for (int ai = 0; ai < 2; ++ai)
#pragma unroll
            for (int m = 0; m < 4; ++m) { bf16_t* rowp = H + (size_t)(row0 + ai * HALF + m * 16) * DFF + col0;
                f32x4 g0 = acc[ai][0][m][0], g1 = acc[ai][0][m][1]; const f32x4 u0 = acc[ai][1][m][0], u1 = acc[ai][1][m][1];
#pragma unroll
                for (int i = 0; i < 4; ++i) { g0[i] = siluf_(g0[i]) * u0[i]; g1[i] = siluf_(g1[i]) * u1[i]; }
                u32x4 w; w.x = cvt_pk_bf16(g0[0], g0[1]); w.y = cvt_pk_bf16(g0[2], g0[3]); w.z = cvt_pk_bf16(g1[0], g1[1]); w.w = cvt_pk_bf16(g1[2], g1[3]);
                *(u32x4*)rowp = w; }
    }
};
}

template <class F> __device__ __forceinline__ void prep_mat(bf16_t* dst, int NR, int K, int gtid, int gthreads, F src) {
    const int total = NR * (K >> 3);
    for (int i = gtid; i < total; i += gthreads) { const int n = i % NR, kb = i / NR; float v[8];
#pragma unroll
        for (int j = 0; j < 8; ++j) v[j] = src(n, kb * 8 + j);
        uint4 o; o.x = pg8::cvt_pk_bf16(v[0], v[1]); o.y = pg8::cvt_pk_bf16(v[2], v[3]); o.z = pg8::cvt_pk_bf16(v[4], v[5]); o.w = pg8::cvt_pk_bf16(v[6], v[7]);
        *(uint4*)(dst + (size_t)n * K + kb * 8) = o; }
}
template <class F, class R> __device__ __forceinline__ void prep_mat_rm(bf16_t* dst, int NR, int K, int gtid, int gthreads, F src, R rowmap) {
    const int total = NR * (K >> 3);
    for (int i = gtid; i < total; i += gthreads) { const int n = i % NR, kb = i / NR; float v[8];
#pragma unroll
        for (int j = 0; j < 8; ++j) v[j] = src(n, kb * 8 + j);
        uint4 o; o.x = pg8::cvt_pk_bf16(v[0], v[1]); o.y = pg8::cvt_pk_bf16(v[2], v[3]); o.z = pg8::cvt_pk_bf16(v[4], v[5]); o.w = pg8::cvt_pk_bf16(v[6], v[7]);
        *(uint4*)(dst + (size_t)rowmap(n) * K + kb * 8) = o; }
}
__device__ __forceinline__ void transpose_item(const float* W  , int ldw, bf16_t* WT  , int K, lfloat* scr, int lane) {
#pragma unroll 8
    for (int i = 0; i < 32; ++i) { const int kk = 2 * i + (lane >> 5); scr[kk * 33 + (lane & 31)] = W[(size_t)kk * ldw + (lane & 31)]; }
    asm volatile("s_waitcnt lgkmcnt(0)" ::: "memory");
    const int c = lane & 7;
#pragma unroll
    for (int jj = 0; jj < 4; ++jj) { const int n = (lane >> 3) + 8 * jj; const lfloat* p = scr + (8 * c) * 33 + n;
        uint4 o; o.x = pg8::cvt_pk_bf16(p[0], p[33]); o.y = pg8::cvt_pk_bf16(p[66], p[99]); o.z = pg8::cvt_pk_bf16(p[132], p[165]); o.w = pg8::cvt_pk_bf16(p[198], p[231]);
        *(uint4*)(WT + (size_t)n * K + 8 * c) = o; }
    asm volatile("s_waitcnt lgkmcnt(0)" ::: "memory");
}
__device__ __forceinline__ void phase_weights_tiled(CArgs* ap, int l, lfloat* lds) {
    const int tid = ltid(), lane = tid & 63, wave = tid >> 6; lfloat* scr = lds + wave * 2176;
    const int gw = lbid() * 8 + wave, ngw = gridDim.x * 8; unsigned char* ws = ap->ws;
    constexpr int I_IN = 16 * 96, I_O = 16 * 32, I_G = 16 * 88, I_D = 44 * 32, NIT = I_IN + I_O + 2 * I_G + I_D;
    for (int it = gw; it < NIT; it += ngw) { CArgs& a = *launder_args(ap); int r = it;
        if (r < I_IN) { const int kb = r / 96, nb = r % 96; transpose_item(a.in[6] + (size_t)l * DM * 3072 + (size_t)(kb * 64) * 3072 + nb * 32, 3072, (bf16_t*)(ws + OFF_WIN) + (size_t)(nb * 32) * DM + kb * 64, DM, scr, lane); continue; } r -= I_IN;
        if (r < I_O) { const int kb = r / 32, nb = r % 32; const int ks = (kb * 64 + 512) & 1023;
            transpose_item(a.in[7] + (size_t)l * DM * DM + (size_t)ks * DM + nb * 32, DM, (bf16_t*)(ws + OFF_WO) + (size_t)(nb * 32) * DM + kb * 64, DM, scr, lane); continue; } r -= I_O;
        if (r < 2 * I_G) { const int up = r >= I_G; if (up) r -= I_G; const int kb = r / 88, nb = r % 88, n0 = nb * 32; const int row0 = (n0 >> 7) * 256 + (n0 & 127) + (up ? 128 : 0);
            const float* W = (up ? a.in[32] : a.in[31]) + (size_t)l * DM * DFF;
            transpose_item(W + (size_t)(kb * 64) * DFF + n0, DFF, (bf16_t*)(ws + OFF_WGU) + (size_t)row0 * DM + kb * 64, DM, scr, lane); continue; } r -= 2 * I_G;
        { const int kb = r / 32, nb = r % 32; transpose_item(a.in[33] + (size_t)l * DFF * DM + (size_t)(kb * 64) * DM + nb * 32, DM, (bf16_t*)(ws + OFF_WD) + (size_t)(nb * 32) * DFF + kb * 64, DFF, scr, lane); }
    }
}
__device__ __forceinline__ void phase_weights(CArgs* ap, int l) {
    const int gtid = lbid() * 512 + ltid(), gth = gridDim.x * 512;
    unsigned char* ws = ap->ws;
    {   CArgs& a = *launder_args(ap);
        const float* mux = a.in[9] + (size_t)l * 3 * DM; const float* w1 = a.in[11] + (size_t)l * DM * 64; const float* a1 = a.in[14] + (size_t)l * DM * 64;
        const float* g1 = a.in[16] + (size_t)l * DM * 128; const float* muv = a.in[23]; const float* v1 = a.in[25]; const float* ga1 = a.in[27] + (size_t)l * DM * 16;
        prep_mat((bf16_t*)(ws + OFF_WIN) + (size_t)3072 * DM, 768, DM, gtid, gth, [=](int n, int k) -> float {
            if (n < 128) { const float mu = mux[k]; const int j = n & 63; return (n < 64 ? 1.f - mu : mu) * w1[k * 64 + j]; }
            if (n < 256) { const float mu = mux[DM + k]; const int j = n & 63; return (n < 192 ? 1.f - mu : mu) * a1[k * 64 + j]; }
            if (n < 512) { const float mu = mux[2 * DM + k]; const int j = n & 127; return (n < 384 ? 1.f - mu : mu) * g1[k * 128 + j]; }
            if (n < 576) { if (l == 0) return 0.f; const float mu = muv[k]; const int j = n & 31; return (n < 544 ? 1.f - mu : mu) * v1[k * 32 + j]; }
            if (n < 592) return ga1[k * 16 + (n - 576)];
            return 0.f; });
    }
    {   CArgs& a = *launder_args(ap);
        const float* w2 = a.in[12] + (size_t)l * 64 * 512; const float* a2 = a.in[15] + (size_t)l * 64 * 512; const float* g2 = a.in[17] + (size_t)l * 128 * 512;
        const float* v2 = a.in[26]; const float* ga2 = a.in[28] + (size_t)l * 16 * 128;
        prep_mat((bf16_t*)(ws + OFF_W2L), N2, K2, gtid, gth, [=](int n, int k) -> float {
            if (n < 512) return k < 64 ? w2[k * 512 + n] : 0.f;
            if (n < 1024) return (k >= 64 && k < 128) ? a2[(k - 64) * 512 + (n - 512)] : 0.f;
            if (n < 1536) return (k >= 128 && k < 256) ? g2[(k - 128) * 512 + (n - 1024)] : 0.f;
            if (n < 2048) return (l == 1 && k >= 256 && k < 288) ? v2[(k - 256) * 512 + (n - 1536)] : 0.f;
            if (n < 2176) return (k >= 288 && k < 304) ? ga2[(k - 288) * 128 + (n - 2048)] : 0.f;
            return 0.f; });
    }
}
__device__ __forceinline__ void phase_adaln(CArgs& a, lfloat* lds) {
    const int tid = ltid(); lfloat* sc = lds; lfloat* part = lds + 4096;
    for (int i = tid; i < 4096; i += 512) sc[i] = siluf_(a.in[1][i]);
    __syncthreads();
    float* mod = (float*)(a.ws + OFF_MOD);
    for (int item = lbid(); item < 2 * 192; item += gridDim.x) {
        const int l = item / 192, col0 = (item % 192) * 32, col = tid & 31, kg = tid >> 5;
        const float* W = a.in[2] + (size_t)l * DM * 6144 + col0 + col;
        float acc0 = 0.f, acc1 = 0.f, acc2 = 0.f, acc3 = 0.f;
#pragma unroll 8
        for (int kk = 0; kk < 64; ++kk) { const int k = kg * 64 + kk; const float w = W[(size_t)k * 6144];
            acc0 += sc[k] * w; acc1 += sc[1024 + k] * w; acc2 += sc[2048 + k] * w; acc3 += sc[3072 + k] * w; }
        part[(kg * 4 + 0) * 32 + col] = acc0; part[(kg * 4 + 1) * 32 + col] = acc1; part[(kg * 4 + 2) * 32 + col] = acc2; part[(kg * 4 + 3) * 32 + col] = acc3;
        __syncthreads();
        if (tid < 128) { const int b = tid >> 5; float s = a.in[3][l * 6144 + col0 + col];
#pragma unroll
            for (int g = 0; g < 16; ++g) s += part[(g * 4 + b) * 32 + col];
            mod[(l * 4 + b) * 6144 + col0 + col] = s; }
        __syncthreads();
    }
}
__device__ __forceinline__ void phase_modnorm(const float* X, const float* g, const float* mod  , int sh_off, bf16_t* out) {
    const int lane = ltid() & 63, gw = lbid() * 8 + (ltid() >> 6), ngw = gridDim.x * 8;
    for (int m = gw; m < MT; m += ngw) {
        const f32x4* xr = (const f32x4*)(X + (size_t)m * DM) + lane; f32x4 v[4]; float s = 0.f;
#pragma unroll
        for (int j = 0; j < 4; ++j) { v[j] = xr[64 * j]; s += sum4(v[j] * v[j]); }
        const float rstd = rsqrtf(wave_sum(s) * (1.f / DM) + 1e-6f);
        const float* mp = mod + (m >> 12) * 6144 + sh_off;
        uint2* o = (uint2*)(out + (size_t)m * DM) + lane;
#pragma unroll
        for (int j = 0; j < 4; ++j) { const int c = 4 * lane + 256 * j; const f32x4 gg = *(const f32x4*)(g + c), sh = *(const f32x4*)(mp + c), sc = *(const f32x4*)(mp + 1024 + c);
            o[64 * j] = pack4(v[j] * rstd * gg * (1.f + sc) + sh); }
    }
}
__device__ __forceinline__ void phase_finalnorm(float* X, const float* g) {
    const int lane = ltid() & 63, gw = lbid() * 8 + (ltid() >> 6), ngw = gridDim.x * 8;
    for (int m = gw; m < MT; m += ngw) {
        f32x4* xr = (f32x4*)(X + (size_t)m * DM) + lane; f32x4 v[4]; float s = 0.f;
#pragma unroll
        for (int j = 0; j < 4; ++j) { v[j] = xr[64 * j]; s += sum4(v[j] * v[j]); }
        const float rstd = rsqrtf(wave_sum(s) * (1.f / DM) + 1e-6f);
#pragma unroll
        for (int j = 0; j < 4; ++j) { const int c = 4 * lane + 256 * j; xr[64 * j] = v[j] * rstd * *(const f32x4*)(g + c); }
    }
}
__device__ __forceinline__ void load8(const bf16_t* p, float (&v)[8]) { const uint4 u = *(const uint4*)p;
    v[0] = __uint_as_float(u.x << 16); v[1] = __uint_as_float(u.x & 0xffff0000u); v[2] = __uint_as_float(u.y << 16); v[3] = __uint_as_float(u.y & 0xffff0000u);
    v[4] = __uint_as_float(u.z << 16); v[5] = __uint_as_float(u.z & 0xffff0000u); v[6] = __uint_as_float(u.w << 16); v[7] = __uint_as_float(u.w & 0xffff0000u); }
__device__ __forceinline__ void store8(bf16_t* p, const float (&v)[8]) { uint4 o; o.x = pg8::cvt_pk_bf16(v[0], v[1]); o.y = pg8::cvt_pk_bf16(v[2], v[3]); o.z = pg8::cvt_pk_bf16(v[4], v[5]); o.w = pg8::cvt_pk_bf16(v[6], v[7]); *(uint4*)p = o; }
__device__ __forceinline__ void phase_loramid(const bf16_t* ZX, bf16_t* A2, const bf16_t* ZR, bf16_t* BND, bf16_t* BND0) {
    const int gtid = lbid() * 512 + ltid(), gth = gridDim.x * 512;
    for (int i = gtid; i < 1024 * 192; i += gth) { const int row = i / 192, q8 = (i % 192) * 8;
        *(uint4*)(BND + (size_t)row * 1536 + q8) = *(const uint4*)(ZR + (size_t)(row * 16 + 15) * 1536 + q8); }
    for (int i = gtid; i < 1024 * 64; i += gth) { const int row = i / 64, q8 = (i % 64) * 8;
        *(uint4*)(BND0 + (size_t)row * 512 + q8) = *(const uint4*)(ZR + (size_t)(row * 16) * 1536 + 512 + q8); }
    for (int i = gtid; i < MT * 48; i += gth) { const int m = i / 48, cg = i % 48, c = cg * 8, t = m & (SEQ - 1);
        const bf16_t* zr = ZX + (size_t)m * 768; float p[8], q[8], o[8];
        int pc, qc, mode;
        if (c < 64) { pc = c; qc = 64 + c; mode = 0; } else if (c < 128) { pc = 128 + (c - 64); qc = 192 + (c - 64); mode = 1; }
        else if (c < 256) { pc = 256 + (c - 128); qc = 384 + (c - 128); mode = 2; } else if (c < 288) { pc = 512 + (c - 256); qc = 544 + (c - 256); mode = 1; }
        else if (c < 304) { pc = 576 + (c - 288); qc = 0; mode = 3; } else { pc = 0; qc = 0; mode = 4; }
        if (mode == 4) {
#pragma unroll
            for (int j = 0; j < 8; ++j) o[j] = 0.f;
        } else {
            load8(zr + pc, p);
            if (mode != 3 && t > 0) load8(zr - 768 + qc, q); else {
#pragma unroll
                for (int j = 0; j < 8; ++j) q[j] = 0.f; }
#pragma unroll
            for (int j = 0; j < 8; ++j) { const float s = p[j] + q[j]; o[j] = mode == 0 ? tanhf_(s) : (mode == 2 ? sigmoidf_(s) : s); }
        }
        store8(A2 + (size_t)m * K2 + c, o); }
}
struct RwConst { f32x4 mu_r, mu_k, mu_v, k_k, k_a, w0, a0, v0; };
__device__ __forceinline__ RwConst rw_load_const(CArgs& a, int l, int c) {
    RwConst k; const float* mu = a.in[8] + (size_t)l * 3 * 512;
    k.mu_r = *(const f32x4*)(mu + c); k.mu_k = *(const f32x4*)(mu + 512 + c); k.mu_v = *(const f32x4*)(mu + 1024 + c);
    k.k_k = *(const f32x4*)(a.in[18] + l * 512 + c); k.k_a = *(const f32x4*)(a.in[19] + l * 512 + c);
    k.w0 = *(const f32x4*)(a.in[10] + l * 512 + c); k.a0 = *(const f32x4*)(a.in[13] + l * 512 + c);
    k.v0 = l ? *(const f32x4*)(a.in[24] + c) : (f32x4){0.f, 0.f, 0.f, 0.f};
    return k;
}
struct RwTok { uint2 r, k, v, wpre, apre, vgpre, vf; };
__device__ __forceinline__ RwTok rw_load_tok(const bf16_t* ZR, const bf16_t* PRE, const bf16_t* VF, int l, int m, int c) {
    RwTok x; const uint2 z = {0u, 0u};
    const uint2* zr = (const uint2*)(ZR + (size_t)m * 1536 + c); x.r = zr[0]; x.k = zr[128]; x.v = zr[256];
    const uint2* pr = (const uint2*)(PRE + (size_t)m * N2 + c); x.wpre = pr[0]; x.apre = pr[128];
    if (l) { x.vgpre = pr[384]; x.vf = *(const uint2*)(VF + (size_t)m * 512 + c); } else { x.vgpre = z; x.vf = z; }
    return x;
}
__device__ __forceinline__ void phase_rwkv_prep(CArgs& a, int l) {
    bf16_t* ZR = (bf16_t*)(a.ws + OFF_ZR); bf16_t* PRE = (bf16_t*)(a.ws + OFF_PRE); bf16_t* VF = (bf16_t*)(a.ws + OFF_VF); const bf16_t* BND = (const bf16_t*)(a.ws + OFF_BND);
    const bf16_t* BND0 = (const bf16_t*)(a.ws + OFF_BND0); float2* C12 = (float2*)(a.ws + OFF_C12);
    const int g16 = (lbid() * 512 + ltid()) >> 4, ng16 = gridDim.x * 32, j = ltid() & 15;
    for (int g = g16; g < 8192; g += ng16) { const int hd = g & 7, run = g >> 3, c = hd * 64 + 4 * j, mbeg = run * 16;
        const RwConst k = rw_load_const(a, l, c);
        uint2 rp = {0u, 0u}, kp = rp, vp = rp;
        if (mbeg & (SEQ - 1)) { const uint2* bp = (const uint2*)(BND + (size_t)(run - 1) * 1536 + c); rp = bp[0]; kp = bp[128]; vp = bp[256]; }
        const bool has_next = ((mbeg + 16) & (SEQ - 1)) != 0;
        uint2 knext = {0u, 0u}; if (has_next) knext = *(const uint2*)(BND0 + (size_t)(run + 1) * 512 + c);
        RwTok cur = rw_load_tok(ZR, PRE, VF, l, mbeg, c);
        f32x4 dprev = {0.f, 0.f, 0.f, 0.f}, kxprev = dprev, bprev = dprev;
        for (int i = 0; i <= 16; ++i) { const int m = mbeg + i;
            RwTok nxt = cur; if (i < 15) nxt = rw_load_tok(ZR, PRE, VF, l, m + 1, c);
            if (i == 16) { cur.k = knext; }
            f32x4 kq = unpack4(cur.k); kq = kq + (unpack4(kp) - kq) * k.mu_k;
            const f32x4 kkv = kq * k.k_k; const float ss = row_allreduce16(sum4(kkv * kkv));
            const float inv = 1.f / fmaxf(sqrtf(ss), 1e-12f);
            f32x4 kk = kkv * inv; if (i == 16 && !has_next) kk = (f32x4){0.f, 0.f, 0.f, 0.f};
            if (i > 0) {
                const float c1 = row_allreduce16(sum4(kxprev * kk)), c2 = row_allreduce16(sum4(bprev * kk));
                *(uint2*)(PRE + (size_t)(m - 1) * N2 + 512 + c) = pack4(dprev * kk);
                if (j == 0) C12[(size_t)(m - 1) * 8 + hd] = make_float2(c1, c2);
            }
            if (i < 16) {
                f32x4 r = unpack4(cur.r), v = unpack4(cur.v);
                r = r + (unpack4(rp) - r) * k.mu_r; v = v + (unpack4(vp) - v) * k.mu_v;
                const f32x4 apre = k.a0 + unpack4(cur.apre), wv = k.w0 + unpack4(cur.wpre); f32x4 av, lw;
#pragma unroll
                for (int q = 0; q < 4; ++q) { av[q] = sigmoidf_(apre[q]); lw[q] = -__expf(-softplusf_(-wv[q]) - 0.5f); }
                const f32x4 kx = kq * (1.f + (av - 1.f) * k.k_a);
                if (l) { const f32x4 vg = k.v0 + unpack4(cur.vgpre), vf = unpack4(cur.vf);
#pragma unroll
                    for (int q = 0; q < 4; ++q) v[q] = v[q] + (vf[q] - v[q]) * sigmoidf_(vg[q]); }
                uint2* zr = (uint2*)(ZR + (size_t)m * 1536 + c); uint2* pr = (uint2*)(PRE + (size_t)m * N2 + c);
                const uint2 lwp = pack4(lw), kxp = pack4(kx), bp4 = pack4(kk * av);
                zr[0] = pack4(r); zr[128] = kxp; const uint2 vpk = pack4(v); zr[256] = vpk;
                pr[0] = lwp; pr[384] = bp4;
                if (l == 0) *(uint2*)(VF + (size_t)m * 512 + c) = vpk;
                const f32x4 lwr = unpack4(lwp); dprev = (f32x4){__expf(lwr[0]), __expf(lwr[1]), __expf(lwr[2]), __expf(lwr[3])}; kxprev = unpack4(kxp); bprev = unpack4(bp4);
                rp = cur.r; kp = cur.k; vp = cur.v; cur = nxt; }
        }
    }
}
constexpr int GL_BC = 0, GL_QA = 2048, GL_QB = GL_QA + 2112, GL_QC = GL_QB + 2112, GL_KA = GL_QC + 2112, GL_KB = GL_KA + 2112, GL_KT = GL_KB + 2112,
              GL_V = GL_KT + 2112, GL_SP = GL_V + 4096, GL_ATT = GL_SP + 2048, GL_END = GL_ATT + 64 * 65;
static_assert(GL_END * 4 <= 131072, "GLA/RET LDS");
__device__ __forceinline__ float ret_log2gamma(int h) { return __log2f(1.f - exp2f(-5.f - (float)h)); }
__device__ __forceinline__ void glaret_setup(CArgs& a, int l, int type, int b, int h, int c, lfloat* lds) {
    const int tid = ltid(); const int m0 = b * SEQ + c * 64;
    const bf16_t* ZG = (const bf16_t*)(a.ws + OFF_ZG); const bf16_t* PRE = (const bf16_t*)(a.ws + OFF_PRE);
    lfloat* bc = lds + GL_BC;
    if (type == 0) {
        { const int t = tid >> 3, d4 = (tid & 7) * 4; const f32x4 x = unpack4(*(const uint2*)(PRE + (size_t)(m0 + t) * N2 + 2048 + h * 32 + d4)) + *(const f32x4*)(a.in[29] + l * 128 + h * 32 + d4);
#pragma unroll
          for (int i = 0; i < 4; ++i) bc[t * 32 + d4 + i] = -softplusf_(-x[i]) * (1.f / 16.f); }
        __syncthreads();
        {
            lfloat* seg = lds + GL_ATT; const int d = tid & 31, sg = tid >> 5;
            float v0 = bc[(sg * 4 + 0) * 32 + d], v1 = v0 + bc[(sg * 4 + 1) * 32 + d], v2 = v1 + bc[(sg * 4 + 2) * 32 + d], v3 = v2 + bc[(sg * 4 + 3) * 32 + d];
            seg[sg * 32 + d] = v3;
            __syncthreads();
            float off = 0.f;
#pragma unroll
            for (int q = 0; q < 15; ++q) off += (q < sg) ? seg[q * 32 + d] : 0.f;
            bc[(sg * 4 + 0) * 32 + d] = v0 + off; bc[(sg * 4 + 1) * 32 + d] = v1 + off; bc[(sg * 4 + 2) * 32 + d] = v2 + off; bc[(sg * 4 + 3) * 32 + d] = v3 + off;
        }
        __syncthreads();
    }
    const float scl = 0.17677669529663687f;
    {
        const int t = tid >> 3, i0 = (tid & 7) * 2; const int qoff = type ? 768 : 0, koff = type ? 896 : 128;
        const bf16_t* zr = ZG + (size_t)(m0 + t) * 1536 + h * 32 + i0;
        const unsigned q1u = *(const unsigned*)(zr + qoff), q2u = *(const unsigned*)(zr + qoff + 16), k1u = *(const unsigned*)(zr + koff), k2u = *(const unsigned*)(zr + koff + 16);
        const float l2g = ret_log2gamma(h);
#pragma unroll
        for (int u = 0; u < 2; ++u) { const int i = i0 + u;
            const float q1 = u ? __uint_as_float(q1u & 0xffff0000u) : __uint_as_float(q1u << 16), q2 = u ? __uint_as_float(q2u & 0xffff0000u) : __uint_as_float(q2u << 16);
            const float k1 = u ? __uint_as_float(k1u & 0xffff0000u) : __uint_as_float(k1u << 16), k2 = u ? __uint_as_float(k2u & 0xffff0000u) : __uint_as_float(k2u << 16);
            const int o1 = t * 33 + i, o2 = t * 33 + i + 16;
            if (type == 0) {
                const float b1 = bc[t * 32 + i], b2 = bc[t * 32 + i + 16], e1 = bc[63 * 32 + i], e2 = bc[63 * 32 + i + 16];
                const float p1 = __expf(b1), m1 = __expf(-b1), p2 = __expf(b2), m2 = __expf(-b2);
                lds[GL_QA + o1] = q1 * scl * p1; lds[GL_QB + o1] = q1 * scl * m1; lds[GL_QC + o1] = q1 * scl * p1; lds[GL_KA + o1] = k1 * m1; lds[GL_KB + o1] = k1 * p1; lds[GL_KT + o1] = k1 * __expf(e1 - b1);
                lds[GL_QA + o2] = q2 * scl * p2; lds[GL_QB + o2] = q2 * scl * m2; lds[GL_QC + o2] = q2 * scl * p2; lds[GL_KA + o2] = k2 * m2; lds[GL_KB + o2] = k2 * p2; lds[GL_KT + o2] = k2 * __expf(e2 - b2);
            } else {
                const float invf = exp2f(-(float)i * 0.8304820237218406f);
                const float ang = (float)(c * 64 + t) * invf; const float nr = rintf(ang * 0.15915494309189535f);
                float rr = fmaf(-nr, 6.28125f, ang); rr = fmaf(-nr, 1.9353071795864769e-3f, rr);
                const float cs = __cosf(rr), sn = __sinf(rr);
                const float qr1 = q1 * cs - q2 * sn, qr2 = q2 * cs + q1 * sn, kr1 = k1 * cs - k2 * sn, kr2 = k2 * cs + k1 * sn;
                const float gq = exp2f(l2g * (float)(t + 1)), gk = exp2f(l2g * (float)(63 - t));
                lds[GL_QA + o1] = qr1 * scl; lds[GL_QB + o1] = qr1 * scl; lds[GL_QC + o1] = qr1 * scl * gq; lds[GL_KA + o1] = kr1; lds[GL_KB + o1] = kr1; lds[GL_KT + o1] = kr1 * gk;
                lds[GL_QA + o2] = qr2 * scl; lds[GL_QB + o2] = qr2 * scl; lds[GL_QC + o2] = qr2 * scl * gq; lds[GL_KA + o2] = kr2; lds[GL_KB + o2] = kr2; lds[GL_KT + o2] = kr2 * gk;
            } }
    }
    {
        const int t = tid >> 3, e8 = (tid & 7) * 8; float v[8]; load8(ZG + (size_t)(m0 + t) * 1536 + (type ? 1024 : 256) + h * 64 + e8, v);
#pragma unroll
        for (int i = 0; i < 8; ++i) lds[GL_V + t * 64 + e8 + i] = v[i];
    }
    __syncthreads();
}
__device__ __forceinline__ void phase_glaret_kv(CArgs& a, int l, lfloat* lds) {
    const int tid = ltid(); float* KV = (float*)(a.ws + OFF_KV); float* DEC = (float*)(a.ws + OFF_DEC);
    for (int uid = lbid(); uid < 2048; uid += gridDim.x) {
        const int type = uid >> 10, bh = (uid >> 6) & 15, c = uid & 63, b = bh >> 2, h = bh & 3;
        glaret_setup(a, l, type, b, h, c, lds);
        const int d = tid >> 4, e4 = (tid & 15) * 4; f32x4 acc = {0.f, 0.f, 0.f, 0.f};
#pragma unroll 8
        for (int t = 0; t < 64; ++t) acc += lds[GL_KT + t * 33 + d] * *(const LAS f32x4*)(lds + GL_V + t * 64 + e4);
        *(f32x4*)(KV + ((size_t)((type * 16 + bh) * 64 + c)) * 2048 + d * 64 + e4) = acc;
        if (type == 0 && tid < 32) DEC[(bh * 64 + c) * 32 + tid] = __expf(lds[GL_BC + 63 * 32 + tid]);
        __syncthreads();
    }
}
__device__ __forceinline__ void phase_glaret_out(CArgs& a, int l, lfloat* lds) {
    const int tid = ltid(); const float* KV = (const float*)(a.ws + OFF_KV);
    const bf16_t* ZG = (const bf16_t*)(a.ws + OFF_ZG); bf16_t* PRE = (bf16_t*)(a.ws + OFF_PRE);
    for (int uid = lbid(); uid < 2048; uid += gridDim.x) {
        const int type = uid >> 10, bh = (uid >> 6) & 15, c = uid & 63, b = bh >> 2, h = bh & 3; const int m0 = b * SEQ + c * 64;
        { const f32x4 s = *(const f32x4*)(KV + ((size_t)((type * 16 + bh) * 64 + c)) * 2048 + tid * 4); *(LAS f32x4*)(lds + GL_SP + tid * 4) = s; }
        glaret_setup(a, l, type, b, h, c, lds);
        const int n = tid >> 3, g8 = (tid & 7) * 8;
        {
            float acc[8];
#pragma unroll
            for (int i = 0; i < 8; ++i) acc[i] = 0.f;
            for (int d = 0; d < 32; ++d) { const float qa = lds[GL_QA + n * 33 + d], qb = lds[GL_QB + n * 33 + d];
#pragma unroll
                for (int i = 0; i < 8; ++i) { const int m = g8 + i; acc[i] += (m <= n) ? qa * lds[GL_KA + m * 33 + d] : qb * lds[GL_KB + m * 33 + d]; } }
            const float l2g = ret_log2gamma(h);
#pragma unroll
            for (int i = 0; i < 8; ++i) { const int m = g8 + i; const float pm = type ? exp2f(l2g * (float)(m > n ? m - n : n - m)) : 1.f; lds[GL_ATT + n * 65 + m] = acc[i] * pm; }
        }
        __syncthreads();
        f32x4 o0 = {0.f, 0.f, 0.f, 0.f}, o1 = {0.f, 0.f, 0.f, 0.f};
#pragma unroll 4
        for (int m = 0; m < 64; ++m) { const float w = lds[GL_ATT + n * 65 + m]; o0 += w * *(const LAS f32x4*)(lds + GL_V + m * 64 + g8); o1 += w * *(const LAS f32x4*)(lds + GL_V + m * 64 + g8 + 4); }
#pragma unroll 4
        for (int d = 0; d < 32; ++d) { const float w = lds[GL_QC + n * 33 + d]; o0 += w * *(const LAS f32x4*)(lds + GL_SP + d * 64 + g8); o1 += w * *(const LAS f32x4*)(lds + GL_SP + d * 64 + g8 + 4); }
        float s1 = sum4(o0) + sum4(o1); s1 += __shfl_xor(s1, 1); s1 += __shfl_xor(s1, 2); s1 += __shfl_xor(s1, 4);
        const float mean = type ? s1 * (1.f / 64.f) : 0.f;
        o0 = o0 - mean; o1 = o1 - mean;
        float s2 = sum4(o0 * o0) + sum4(o1 * o1); s2 += __shfl_xor(s2, 1); s2 += __shfl_xor(s2, 2); s2 += __shfl_xor(s2, 4);
        const float rs = rsqrtf(s2 * (1.f / 64.f) + 1e-6f);
        o0 = o0 * rs; o1 = o1 * rs;
        if (type == 0) { const float* lg = a.in[30] + l * 64 + g8; o0 = o0 * *(const f32x4*)lg; o1 = o1 * *(const f32x4*)(lg + 4); }
        float gt[8]; load8(ZG + (size_t)(m0 + n) * 1536 + (type ? 1280 : 512) + h * 64 + g8, gt);
        float ov[8];
#pragma unroll
        for (int i = 0; i < 4; ++i) { ov[i] = o0[i] * siluf_(gt[i]); ov[4 + i] = o1[i] * siluf_(gt[4 + i]); }
        store8(PRE + (size_t)(m0 + n) * N2 + type * 256 + h * 64 + g8, ov);
        __syncthreads();
    }
}
__device__ __forceinline__ void phase_rwkv_out(CArgs& a, int l) {
    const bf16_t* ZR = (const bf16_t*)(a.ws + OFF_ZR); bf16_t* PRE = (bf16_t*)(a.ws + OFF_PRE); const bf16_t* YS = (const bf16_t*)(a.ws + OFF_YS);
    const int g16 = (lbid() * 512 + ltid()) >> 4, ng16 = gridDim.x * 32, j = ltid() & 15;
    for (int it = g16; it < MT * 8; it += ng16) { const int m = it >> 3, hd = it & 7, c = hd * 64 + 4 * j;
        const uint2* zr = (const uint2*)(ZR + (size_t)m * 1536 + c);
        const f32x4 r = unpack4(zr[0]), kx = unpack4(zr[128]), v = unpack4(zr[256]);
        const f32x4 g4 = unpack4(*(const uint2*)(PRE + (size_t)m * N2 + 1024 + c));
        const f32x4 y4 = unpack4(*(const uint2*)(YS + (size_t)m * 512 + c));
        const f32x4 rk = *(const f32x4*)(a.in[20] + l * 512 + c);
        const float bonus = row_allreduce16(sum4(r * kx * rk));
        const float mean = row_allreduce16(sum4(y4)) * (1.f / 64.f); const f32x4 yc = y4 - mean;
        const float var = row_allreduce16(sum4(yc * yc)) * (1.f / 64.f); const float rs = rsqrtf(var + 64e-5f);
        const f32x4 lg = *(const f32x4*)(a.in[21] + l * 512 + c), lb = *(const f32x4*)(a.in[22] + l * 512 + c);
        const f32x4 res = (yc * rs * lg + lb + bonus * v) * g4;
        *(uint2*)(PRE + (size_t)m * N2 + 512 + c) = pack4(res);
    }
}
__device__ __forceinline__ void phase_scan(CArgs& a, int l, lfloat* lds, bool do_chunks) {
    const int tid = ltid(), bid = lbid();
    {
        const int gid = bid * 512 + tid;
        if (do_chunks && gid < 65536) { const int type = gid >> 15, r = gid & 32767, bh = r >> 11, elem = r & 2047, d = elem >> 6, h = bh & 3;
            float* base = (float*)(a.ws + OFF_KV) + ((size_t)((type * 16 + bh) * 64)) * 2048 + elem; const float* dec = (const float*)(a.ws + OFF_DEC) + (size_t)(bh * 64) * 32 + d;
            const float rdec = exp2f(ret_log2gamma(h) * 64.f); float s = 0.f;
            for (int c0 = 0; c0 < 64; c0 += 8) { float kv[8], dc[8];
#pragma unroll
                for (int u = 0; u < 8; ++u) { kv[u] = base[(size_t)(c0 + u) * 2048]; dc[u] = type ? rdec : dec[(c0 + u) * 32]; }
#pragma unroll
                for (int u = 0; u < 8; ++u) { base[(size_t)(c0 + u) * 2048] = s; s = s * dc[u] + kv[u]; } }
        }
    }
    const int bh = bid & 31, rg = bid >> 5, b = bh >> 3, hd = bh & 7, wave = tid >> 6, lane = tid & 63;
    const int m0 = b * SEQ;
    const bf16_t* ZR = (const bf16_t*)(a.ws + OFF_ZR); const bf16_t* PRE = (const bf16_t*)(a.ws + OFF_PRE); bf16_t* YS = (bf16_t*)(a.ws + OFF_YS);
    constexpr int TB = 32, NBLK = SEQ / TB, REC = 28, STEP = 16 * REC, BUF = TB * STEP, PBUF = TB * 64, POFF = 2 * BUF;
    static_assert((2 * BUF + 2 * PBUF) * 4 <= 131072, "scan LDS");
    const bool stager = wave >= 4, scanner = wave < 2; const int st = tid - 256, j = st & 15, c = hd * 64 + 4 * j, tok0 = st >> 4;
    const float2* C12 = (const float2*)(a.ws + OFF_C12);
    struct StRaw { u32x2 r, kx, v, lw, kk, b, cc; };
    StRaw ra, rb, sa, sb;
#define ST_LOAD(dst, m) do { const bf16_t* zr_ = ZR + (size_t)(m) * 1536 + c; const bf16_t* pr_ = PRE + (size_t)(m) * N2 + c; \
        asm volatile("global_load_dwordx2 %0, %1, off" : "=v"(dst.r) : "v"(zr_) : "memory"); \
        asm volatile("global_load_dwordx2 %0, %1, off offset:1024" : "=v"(dst.kx) : "v"(zr_) : "memory"); \
        asm volatile("global_load_dwordx2 %0, %1, off offset:2048" : "=v"(dst.v) : "v"(zr_) : "memory"); \
        asm volatile("global_load_dwordx2 %0, %1, off" : "=v"(dst.lw) : "v"(pr_) : "memory"); \
        asm volatile("global_load_dwordx2 %0, %1, off offset:1024" : "=v"(dst.kk) : "v"(pr_) : "memory"); \
        asm volatile("global_load_dwordx2 %0, %1, off offset:3072" : "=v"(dst.b) : "v"(pr_) : "memory"); \
        { const float2* cp_ = C12 + (size_t)(m) * 8 + hd; asm volatile("global_load_dwordx2 %0, %1, off" : "=v"(dst.cc) : "v"(cp_) : "memory"); } } while (0)
#define ST_PIN(dst) asm volatile("" : "+v"(dst.r), "+v"(dst.kx), "+v"(dst.v), "+v"(dst.lw), "+v"(dst.kk), "+v"(dst.b), "+v"(dst.cc))
#define ST_PUT(src, tok, blk) do { lfloat* q_ = lds + ((blk) & 1) * BUF + (tok) * STEP + j * REC; f32x4 w_ = unpack4(src.lw); \
        w_[0] = __expf(w_[0]); w_[1] = __expf(w_[1]); w_[2] = __expf(w_[2]); w_[3] = __expf(w_[3]); \
        *(LAS f32x4*)(q_) = w_; *(LAS f32x4*)(q_ + 4) = unpack4(src.kk); *(LAS f32x4*)(q_ + 8) = unpack4(src.b); *(LAS f32x4*)(q_ + 12) = unpack4(src.kx); \
        *(LAS f32x4*)(q_ + 16) = unpack4(src.r); *(LAS f32x4*)(q_ + 20) = unpack4(src.v); *(LAS u32x2*)(q_ + 24) = src.cc; } while (0)
#define ST_REDUCE(blk) do { const int tt_ = st >> 3, w_ = (st >> 2) & 1, rl_ = st & 3; \
        const LAS unsigned short* p_ = (const LAS unsigned short*)(lds + POFF + ((blk) & 1) * PBUF) + tt_ * 128 + w_ * 64 + rl_ * 16; \
        const pg8::u32x4 a0_ = *(const LAS pg8::u32x4*)p_, a1_ = *(const LAS pg8::u32x4*)(p_ + 8); \
        float s_ = ((bf2f(a0_[0] & 0xffffu) + bf2f(a0_[0] >> 16)) + (bf2f(a0_[1] & 0xffffu) + bf2f(a0_[1] >> 16))) + ((bf2f(a0_[2] & 0xffffu) + bf2f(a0_[2] >> 16)) + (bf2f(a0_[3] & 0xffffu) + bf2f(a0_[3] >> 16))); \
        s_ += ((bf2f(a1_[0] & 0xffffu) + bf2f(a1_[0] >> 16)) + (bf2f(a1_[1] & 0xffffu) + bf2f(a1_[1] >> 16))) + ((bf2f(a1_[2] & 0xffffu) + bf2f(a1_[2] >> 16)) + (bf2f(a1_[3] & 0xffffu) + bf2f(a1_[3] >> 16))); \
        YS[(size_t)(m0 + (blk) * TB + tt_) * 512 + hd * 64 + rg * 8 + w_ * 4 + rl_] = f2bf1(s_); } while (0)
    if (stager) { ST_LOAD(ra, m0 + tok0); ST_LOAD(rb, m0 + tok0 + 16); asm volatile("s_waitcnt vmcnt(0)" ::: "memory"); ST_PIN(ra); ST_PIN(rb); ST_PUT(ra, tok0, 0); ST_PUT(rb, tok0 + 16, 0);
        ST_LOAD(ra, m0 + TB + tok0); ST_LOAD(rb, m0 + TB + tok0 + 16); ST_LOAD(sa, m0 + 2 * TB + tok0); ST_LOAD(sb, m0 + 2 * TB + tok0 + 16); }
    LDS_BARRIER();
    typedef float f32x2s __attribute__((ext_vector_type(2)));
    f32x4 S = {0.f, 0.f, 0.f, 0.f}; float dk = 0.f;
    const int q = lane & 15, vrow = rg * 8 + (wave & 1) * 4 + (lane >> 4);
#define SCAN_BODY(i, XA, XB) do { \
        if (stager) { \
            if ((i) + 1 < NBLK) { if ((i) + 2 < NBLK) asm volatile("s_waitcnt vmcnt(14)" ::: "memory"); else asm volatile("s_waitcnt vmcnt(0)" ::: "memory"); ST_PIN(XA); ST_PIN(XB); ST_PUT(XA, tok0, (i) + 1); ST_PUT(XB, tok0 + 16, (i) + 1); }     \
            if ((i) > 0) ST_REDUCE((i) - 1); \
            if ((i) + 3 < NBLK) { const int t3_ = m0 + ((i) + 3) * TB + tok0; ST_LOAD(XA, t3_); ST_LOAD(XB, t3_ + 16); } \
        } else if (scanner) { \
            const lfloat* buf = lds + ((i) & 1) * BUF + q * REC; const lfloat* vb = lds + ((i) & 1) * BUF + (vrow >> 2) * REC + 20 + (vrow & 3); \
            LAS unsigned short* pp = (LAS unsigned short*)(lds + POFF + ((i) & 1) * PBUF) + (wave & 1) * 64 + lane; \
            f32x4 XW[3], XK[3], XB_[3], XX[3], XR[3]; float VV[3]; f32x2s XC[3]; \
            _Pragma("unroll") for (int t_ = 0; t_ < 2; ++t_) { const lfloat* p = buf + t_ * STEP; XW[t_] = *(const LAS f32x4*)p; XK[t_] = *(const LAS f32x4*)(p + 4); XB_[t_] = *(const LAS f32x4*)(p + 8); XX[t_] = *(const LAS f32x4*)(p + 12); XR[t_] = *(const LAS f32x4*)(p + 16); XC[t_] = *(const LAS f32x2s*)(p + 24); VV[t_] = vb[t_ * STEP]; } \
            _Pragma("unroll") for (int tt = 0; tt < TB; ++tt) { \
                if (tt + 2 < TB) { const lfloat* p = buf + (tt + 2) * STEP; const int s_ = (tt + 2) % 3; XW[s_] = *(const LAS f32x4*)p; XK[s_] = *(const LAS f32x4*)(p + 4); XB_[s_] = *(const LAS f32x4*)(p + 8); XX[s_] = *(const LAS f32x4*)(p + 12); XR[s_] = *(const LAS f32x4*)(p + 16); XC[s_] = *(const LAS f32x2s*)(p + 24); VV[s_] = vb[(tt + 2) * STEP]; } \
                const f32x4 w = XW[tt % 3], kk = XK[tt % 3], bb = XB_[tt % 3], kx = XX[tt % 3], r = XR[tt % 3]; const float vv = VV[tt % 3]; \
                if (XTRA_LDS) { f32x4 d0_ = *(const LAS f32x4*)(buf + tt * STEP + 4), d1_ = *(const LAS f32x4*)(buf + tt * STEP + 8); asm volatile("" :: "v"(d0_), "v"(d1_)); } \
                const f32x2s cc = XC[tt % 3]; const float A_ = row_allreduce16(sum4(S * kk));     \
                const float pre_ = vv * cc[0] - dk * cc[1]; \
                S = S * w + (vv * kx - dk * bb); \
                pp[tt * 128] = (unsigned short)(__float_as_uint(sum4(S * r)) >> 16); dk = A_ + pre_; }     \
        } \
        LDS_BARRIER(); } while (0)
    for (int i = 0; i < NBLK; i += 2) { SCAN_BODY(i, ra, rb); SCAN_BODY(i + 1, sa, sb); }
    if (stager) ST_REDUCE(NBLK - 1);
    asm volatile("s_waitcnt vmcnt(0)" ::: "memory");
#undef SCAN_BODY
#undef ST_REDUCE
#undef ST_LOAD
#undef ST_PIN
#undef ST_PUT
}
#define GAS __attribute__((address_space(1)))
constexpr size_t OFF_BAR = 512 * 1024, BAR_BYTES = 16384;
#define XB_TMO      128
#define XB_XCNT(j)  (256  + 64 * (j))
#define XB_XSUB(j)  (1280 + 64 * (j))
#define XB_XGEN(j)  (2304 + 64 * (j))
#define XB_TOP      3328
#define XB_TOPGEN   3392
#define XCD_BAR_WORDS 3456
#define XB_SPIN_CAP (1u << 18)

__device__ __forceinline__ unsigned xb_ld(unsigned* p)              { return __hip_atomic_load(p, __ATOMIC_RELAXED, __HIP_MEMORY_SCOPE_AGENT); }
__device__ __forceinline__ unsigned xb_add(unsigned* p, unsigned v) { return __hip_atomic_fetch_add(p, v, __ATOMIC_RELAXED, __HIP_MEMORY_SCOPE_AGENT); }
__device__ __forceinline__ unsigned xb_xcc_id() { return (unsigned)__builtin_amdgcn_s_getreg((3 << 11) | 20) & 0xFu; }
#define XB_SPIN(cond, bar) do { unsigned _sp = 0; while (cond) { __builtin_amdgcn_s_sleep(1); \
    if ((++_sp & 255u) == 0u) { if (xb_ld(&(bar)[XB_TMO])) break; if (_sp > XB_SPIN_CAP) { atomicAdd(&(bar)[XB_TMO], 1u); break; } } } } while (0)

struct XcdBarrier {
    unsigned* bar; unsigned x;
    volatile LAS unsigned* st;
};

__device__ __forceinline__ XcdBarrier xcd_barrier_post(unsigned* bar, volatile LAS unsigned* st) {
    XcdBarrier b; b.bar = bar; b.x = xb_xcc_id(); b.st = st;
    if (threadIdx.x == 0) (void)xb_add(&bar[XB_XCNT(b.x)], 1u);
    return b;
}
__device__ __forceinline__ void xcd_barrier_complete(unsigned* bar, unsigned x, unsigned& nloc, unsigned& nx) {
    const unsigned G = gridDim.x * gridDim.y * gridDim.z;
    unsigned sum, cnt, mine, sp = 0u;
    for (;;) {
        sum = 0u; cnt = 0u; mine = 0u;
#pragma unroll
        for (unsigned j = 0; j < 16; ++j) { const unsigned c = xb_ld(&bar[XB_XCNT(j)]); sum += c; cnt += (c > 0u) ? 1u : 0u; mine = (j == x) ? c : mine; }
        if (sum == G) break;
        __builtin_amdgcn_s_sleep(1);
        if ((++sp & 255u) == 0u) { if (xb_ld(&bar[XB_TMO])) break; if (sp > XB_SPIN_CAP) { atomicAdd(&bar[XB_TMO], 1u); break; } }
    }
    nloc = mine > 0u ? mine : 1u; nx = cnt > 0u ? cnt : 1u;
}

__device__ __forceinline__ void xcd_barrier(const XcdBarrier& b) {
    asm volatile("s_waitcnt vmcnt(0)" ::: "memory");
    __syncthreads();
    if (threadIdx.x == 0) {
        unsigned* bar = b.bar;
        __builtin_amdgcn_s_waitcnt(0);
        unsigned nloc = b.st[0], nx = b.st[1];
        if (nloc == 0u) { xcd_barrier_complete(bar, b.x, nloc, nx); b.st[0] = nloc; b.st[1] = nx; }
        const unsigned old = xb_add(&bar[XB_XSUB(b.x)], 1u);
        const unsigned gen = old / nloc;
        if (old + 1u == (gen + 1u) * nloc) {
            __builtin_amdgcn_fence(__ATOMIC_RELEASE, "agent");
            asm volatile("s_waitcnt vmcnt(0)" ::: "memory");
            const unsigned og = xb_add(&bar[XB_TOP], 1u);
            const unsigned tg = og / nx;
            if (og + 1u == (tg + 1u) * nx) xb_add(&bar[XB_TOPGEN], 1u);
            else XB_SPIN(xb_ld(&bar[XB_TOPGEN]) == tg, bar);
            __builtin_amdgcn_fence(__ATOMIC_ACQUIRE, "agent");
            xb_add(&bar[XB_XGEN(b.x)], 1u);
            asm volatile("s_waitcnt vmcnt(0)" ::: "memory");
        } else {
            XB_SPIN(xb_ld(&bar[XB_XGEN(b.x)]) == gen, bar);
            __builtin_amdgcn_fence(__ATOMIC_ACQUIRE, "agent");
            asm volatile("s_waitcnt vmcnt(0)" ::: "memory");
        }
    }
    __syncthreads();
}

__global__ void __launch_bounds__(512, 2) mega_fwd(Args a_unused) {
    CArgs* ap0 = (CArgs*)__builtin_amdgcn_kernarg_segment_ptr();
    extern __shared__ __attribute__((aligned(16))) unsigned char lds_raw[];
    LAS unsigned char* ldsb = (LAS unsigned char*)lds_raw; lfloat* ldsf = (lfloat*)lds_raw;
    cg::grid_group grid = cg::this_grid();
    const int ph_lo = ap0->ph_lo, ph_hi = ap0->ph_hi, coop = ap0->coop;
    volatile LAS unsigned* MISC = (volatile LAS unsigned*)(ldsb + 131072);
    if (threadIdx.x < 16) MISC[threadIdx.x] = 0u;
    __syncthreads();
    const XcdBarrier xbar = xcd_barrier_post((unsigned*)(ap0->ws + OFF_BAR), MISC + 8);
    for (int ph = ph_lo; ph < ph_hi; ++ph) {
        const int l = ph / NPH, k = ph % NPH;
        const int nrep = (ph < NL * NPH && ((DUPMASK >> k) & 1)) ? 2 : 1;
        for (int rep = 0; rep < nrep; ++rep) {
        if (rep) { if (coop == 2) grid.sync(); else if (coop) xcd_barrier(xbar); }
        CArgs* ap = launder_args(ap0); CArgs& a = *ap;
        unsigned char* ws = a.ws; const int G = gridDim.x, bx = lbid();
        float* MOD = (float*)(ws + OFF_MOD);
        bf16_t* XN = (bf16_t*)(ws + OFF_XN); bf16_t* ZR = (bf16_t*)(ws + OFF_ZR); bf16_t* ZG = (bf16_t*)(ws + OFF_ZG); bf16_t* ZX = (bf16_t*)(ws + OFF_ZX);
        bf16_t* PRE = (bf16_t*)(ws + OFF_PRE); bf16_t* HFF = (bf16_t*)(ws + OFF_HFF);
        const float* mod = MOD + l * 4 * 6144;
        if (ph == NL * NPH) { phase_finalnorm(a.out, a.in[34]); }
        else if (k == 0 && (PHMASK & 1)) { if (l == 0) phase_adaln(a, ldsf); phase_weights(ap, l); __syncthreads(); phase_weights_tiled(ap, l, ldsf); }
        else if (k == 1 && (PHMASK >> 1 & 1)) { phase_modnorm(l == 0 ? a.in[0] : a.out, a.in[4] + l * DM, mod, 0, XN); }
        else if (k == 2 && (PHMASK >> 2 & 1)) { pg8::Gemm g{XN, (const bf16_t*)(ws + OFF_WIN), MT, NIN, DM, DM}; pg8::StaticOrder S; S.init(MT, NIN, G, bx); pg8::EpiIn E{ZR, ZG, ZX};
            pg8::gemm_phase<pg8::EpiIn, pg8::StaticOrder, true, true>(ldsb, g, S, E); }
        else if (k == 3 && (PHMASK >> 3 & 1)) { phase_loramid(ZX, XN, ZR, (bf16_t*)(ws + OFF_BND), (bf16_t*)(ws + OFF_BND0)); }
        else if (k == 4 && (PHMASK >> 4 & 1)) { pg8::Gemm g{XN, (const bf16_t*)(ws + OFF_W2L), MT, N2, K2, K2}; pg8::StaticOrder S; S.init(MT, N2, G, bx); pg8::EpiPlain E{PRE, N2};
            pg8::gemm_phase<pg8::EpiPlain, pg8::StaticOrder, true, true>(ldsb, g, S, E); }
        else if (k == 5 && (PHMASK >> 5 & 1)) { phase_rwkv_prep(a, l); phase_glaret_kv(a, l, ldsf); }
        else if (k == 6 && (PHMASK >> 6 & 1)) { phase_scan(a, l, ldsf, rep == 0); }
        else if (k == 7 && (PHMASK >> 7 & 1)) { phase_rwkv_out(a, l); phase_glaret_out(a, l, ldsf); }
        else if (k == 8 && (PHMASK >> 8 & 1)) { pg8::Gemm g{PRE, (const bf16_t*)(ws + OFF_WO), MT, DM, DM, N2}; pg8::StaticOrder S; S.init(MT, DM, G, bx); pg8::EpiRes E{l == 0 ? a.in[0] : a.out, a.out, mod + 2048};
            pg8::gemm_phase<pg8::EpiRes, pg8::StaticOrder, true, true>(ldsb, g, S, E); }
        else if (k == 9 && (PHMASK >> 9 & 1)) { phase_modnorm(a.out, a.in[5] + l * DM, mod, 3072, XN); }
        else if (k == 10 && (PHMASK >> 10 & 1)) { pg8::Gemm g{XN, (const bf16_t*)(ws + OFF_WGU), MT, NGU, DM, DM}; pg8::StaticOrder S; S.init(MT, NGU, G, bx); pg8::EpiSwiGLU E{HFF};
            pg8::gemm_phase<pg8::EpiSwiGLU, pg8::StaticOrder, true, true>(ldsb, g, S, E); }
        else if (PHMASK >> 11 & 1) { pg8::Gemm g{HFF, (const bf16_t*)(ws + OFF_WD), MT, DM, DFF, DFF}; pg8::StaticOrder S; S.init(MT, DM, G, bx); pg8::EpiRes E{a.out, a.out, mod + 5120};
            pg8::gemm_phase<pg8::EpiRes, pg8::StaticOrder, true, true>(ldsb, g, S, E); }
        }
        if (ph + 1 < ph_hi) { if (coop == 2) grid.sync(); else if (coop) { xcd_barrier(xbar); for (int xs = 0; xs < EXTRA_SYNCS; ++xs) xcd_barrier(xbar); } }
    }
}

constexpr int LDS_BYTES = 147456;
extern "C" void kernel_launch(void* const* d_in, const int* in_sizes, int n_in, void* d_out, int out_size, void* d_ws, size_t ws_size, hipStream_t stream) {
    static int grid = 0;
    if (grid == 0) {
        if (n_in != 35 || out_size != MT * DM || ws_size < OFF_END) { fprintf(stderr, "kernel_launch: unexpected problem (n_in %d out %d ws %zu)\n", n_in, out_size, ws_size); grid = -1; return; }
        int dev = 0, cus = 0, per_cu = 0;
        hipGetDevice(&dev); hipDeviceGetAttribute(&cus, hipDeviceAttributeMultiprocessorCount, dev);
        hipFuncSetAttribute((const void*)mega_fwd, hipFuncAttributeMaxDynamicSharedMemorySize, LDS_BYTES);
        hipOccupancyMaxActiveBlocksPerMultiprocessor(&per_cu, (const void*)mega_fwd, 512, LDS_BYTES);
        if (per_cu < 1) { fprintf(stderr, "kernel_launch: occupancy query says %d blocks per CU\n", per_cu); per_cu = 1; }
        (void)hipGetLastError();
        grid = cus;
    }
    if (grid < 0) return;
    Args a{};
    for (int i = 0; i < 35; ++i) a.in[i] = (const float*)d_in[i];
    a.out = (float*)d_out; a.ws = (unsigned char*)d_ws;
#if MK_MULTI
    for (int ph = 0; ph <= NL * NPH; ++ph) { a.ph_lo = ph; a.ph_hi = ph + 1; a.coop = 0; hipLaunchKernelGGL(mega_fwd, dim3(grid), dim3(512), LDS_BYTES, stream, a); }
#else
    a.ph_lo = 0; a.ph_hi = NL * NPH + 1; a.coop = 1;
    if (hipMemsetAsync((unsigned char*)d_ws + OFF_BAR, 0, BAR_BYTES, stream) != hipSuccess) { fprintf(stderr, "memset failed\n"); return; }
    void* args[] = {&a};
    hipError_t e = hipLaunchCooperativeKernel((const void*)mega_fwd, dim3(grid), dim3(512), args, LDS_BYTES, stream);
    if (e != hipSuccess) fprintf(stderr, "cooperative launch failed: %s (grid %d)\n", hipGetErrorString(e), grid);
#endif
}
```

```cpp
#include <hip/hip_runtime.h>
#include <hip/hip_cooperative_groups.h>
#include <cstdio>
#include <cstdint>
namespace cg = cooperative_groups;
#ifndef MK_MULTI
#define MK_MULTI 0
#endif
__device__ __forceinline__ int ltid() { int t = threadIdx.x; asm volatile("" : "+v"(t)); return t; }
__device__ __forceinline__ int lbid() { int b = blockIdx.x; asm volatile("" : "+s"(b)); return b; }
namespace pg8 {
#define PG8_LAS __attribute__((address_space(3)))
typedef unsigned short bf16_t;
typedef short bf16x8 __attribute__((ext_vector_type(8)));
typedef float f32x4 __attribute__((ext_vector_type(4)));
typedef unsigned u32x4 __attribute__((ext_vector_type(4)));
constexpr int BM = 256, BK = 64, HALF = 128, HTB = HALF * BK * 2  , STAGE_BYTES = 8 * HTB, NXCD = 8, WGM = 8;

__host__ __device__ __forceinline__ int lds_byte(int r, int c) { const int st = (r >> 4) * 2 + (c >> 5), rr = r & 15, cc = c & 31, ob = rr * 64 + cc * 2; return st * 1024 + (ob ^ (((ob >> 9) & 1) << 5)); }
__host__ __device__ __forceinline__ void stage_rc(int b, int& R, int& C) { const int st = b / 1024, sb = b % 1024, swz = sb ^ (((sb >> 9) & 1) << 5); R = (st >> 1) * 16 + swz / 64; C = (st & 1) * 32 + (swz % 64) / 2; }
__host__ __device__ __forceinline__ int perm32(int rho) { const int n = rho >> 4, i = rho & 15; return 8 * (i >> 2) + 4 * n + (i & 3); }

struct Unit { int pm, pn; };
struct Gemm { const bf16_t* A; const bf16_t* Bt; int M, N, K, lda; };

struct StaticOrder {
    int nM, nN, nwg, G, c;
    __host__ __device__ void init(int M, int N, int G_, int c_) { nM = M / BM; nN = N / BM; nwg = nM * nN; G = G_; c = c_; }
    __host__ __device__ bool next(int i, Unit& u) const {
        const long L = (long)i * G + c; if (L >= nwg) return false;
        int wgid = (int)L; { const int q = nwg / NXCD, r = nwg % NXCD, xcd = wgid % NXCD, off = wgid / NXCD; wgid = (xcd < r ? xcd * (q + 1) : r * (q + 1) + (xcd - r) * q) + off; }
        const int nig = WGM * nN, gid = wgid / nig, fm = gid * WGM, gsz = (nM - fm) < WGM ? (nM - fm) : WGM;
        u.pm = fm + ((wgid % nig) % gsz); u.pn = (wgid % nig) / gsz; return true;
    }
    __device__ __forceinline__ void a_ready(const Unit&) const {}
    __device__ __forceinline__ void done(const Unit&) const {}
};

__device__ __forceinline__ unsigned cvt_pk_bf16(float lo, float hi) { unsigned r; asm volatile("v_cvt_pk_bf16_f32 %0, %1, %2" : "=v"(r) : "v"(lo), "v"(hi)); return r; }
typedef float f32x2 __attribute__((ext_vector_type(2)));
__device__ __forceinline__ f32x2 gelu_pk(f32x2 v) {
    const f32x2 av = __builtin_elementwise_abs(v), d = av * 0.2316418882f + 1.0f;
    f32x2 t; t.x = __builtin_amdgcn_rcpf(d.x); t.y = __builtin_amdgcn_rcpf(d.y);
    f32x2 q = t * 0.5307027145f + (-0.7265760135f); q = q * t + 0.7107068705f; q = q * t + (-0.142248368f); q = q * t + 0.127414796f; q = q * t;
    const f32x2 s = (v * v) * (-0.72134752044f);
    f32x2 e; e.x = __builtin_amdgcn_exp2f(s.x); e.y = __builtin_amdgcn_exp2f(s.y);
    const f32x2 m = v * (q * e), r = v - m;
    f32x2 o; o.x = v.x < 0.f ? m.x : r.x; o.y = v.y < 0.f ? m.y : r.y; return o;
}

template <int ACT  > struct EpiBf16 {
    static constexpr bool PERM = true, AFTER_DRAIN = false; static_assert(ACT == 0 || ACT == 1, "EpiBf16: ACT is 0 (none) or 1 (gelu_pk)");
    bf16_t* O; int ldc; const float* bias; int split_cols; size_t split_stride; float scale0;
    __device__ __forceinline__ void operator()(const f32x4 (&acc)[2][2][4][2], const Unit& u, int wr, int wc, int fr, int fq) const {
        const int row0 = u.pm * BM + wr * 64 + fr; int colt = u.pn * BM; bf16_t* base = O;
        float sc = 1.f; if (split_cols) { const int t = colt / split_cols; base += (size_t)t * split_stride; colt -= t * split_cols; if (t == 0) sc = scale0; }
        const int col0 = colt + wc * 32 + 8 * fq, bcol0 = u.pn * BM + wc * 32 + 8 * fq;
        f32x4 bv[2][2];
#pragma unroll
        for (int bj = 0; bj < 2; ++bj)
#pragma unroll
            for (int n = 0; n < 2; ++n) bv[bj][n] = bias ? *(const f32x4*)(bias + bcol0 + bj * HALF + 4 * n) : (f32x4){0.f, 0.f, 0.f, 0.f};
#pragma unroll
        for (int ai = 0; ai < 2; ++ai)
#pragma unroll
            for (int m = 0; m < 4; ++m) { bf16_t* rowp = base + (size_t)(row0 + ai * HALF + m * 16) * ldc + col0;
#pragma unroll
                for (int bj = 0; bj < 2; ++bj) { f32x4 v0 = acc[ai][bj][m][0] + bv[bj][0], v1 = acc[ai][bj][m][1] + bv[bj][1];
                    if (ACT == 1) { f32x2 a = gelu_pk((f32x2){v0[0], v0[1]}), b = gelu_pk((f32x2){v0[2], v0[3]}), c = gelu_pk((f32x2){v1[0], v1[1]}), d = gelu_pk((f32x2){v1[2], v1[3]});
                        v0 = (f32x4){a.x, a.y, b.x, b.y}; v1 = (f32x4){c.x, c.y, d.x, d.y}; }
                    v0 = v0 * sc; v1 = v1 * sc; u32x4 w; w.x = cvt_pk_bf16(v0[0], v0[1]); w.y = cvt_pk_bf16(v0[2], v0[3]); w.z = cvt_pk_bf16(v1[0], v1[1]); w.w = cvt_pk_bf16(v1[2], v1[3]);
                    *(u32x4*)(rowp + bj * HALF) = w; } }
    }
};
template <class Epi, class Sched, bool ALIGN_EPI = false, bool SP2 = false>
__device__ __forceinline__ void gemm_phase(PG8_LAS unsigned char* lds, const Gemm g, const Sched& S, const Epi& E) {
    const int tid = ltid(), wid = __builtin_amdgcn_readfirstlane(tid >> 6), lane = tid & 63, wr = wid >> 2, wc = wid & 3, fr = lane & 15, fq = lane >> 4;
    const int K = g.K, nt = K / BK;
    unsigned voffA[2], voffB[2];
#pragma unroll
    for (int i = 0; i < 2; ++i) { int R, C; stage_rc(tid * 16 + i * 8192, R, C); const int Rb = Epi::PERM ? ((R & ~31) + perm32(R & 31)) : R;
        voffA[i] = (unsigned)(R * g.lda + C) * 2u; voffB[i] = (unsigned)(Rb * K + C) * 2u; }
    const size_t kstep = (size_t)(BK * 2);
    const size_t hstep = (size_t)HALF * K * 2;
    const size_t tstep = 2 * hstep; const size_t hstepA = (size_t)HALF * g.lda * 2, tstepA = 2 * hstepA;
    const unsigned ldsw = (unsigned)wid * 1024u;
    const int aoff = lds_byte(wr * 64 + fr, fq * 8), boff = lds_byte(wc * 32 + fr, fq * 8);
#define PG8_SA(b, h) (((b) * 2 + (h)) * HTB)
#define PG8_SB(b, h) ((4 + (b) * 2 + (h)) * HTB)
#define PG8_STAGE(bufoff, gbase, voff) do { _Pragma("unroll") for (int _i = 0; _i < 2; ++_i) \
        __builtin_amdgcn_global_load_lds((const unsigned*)((const char*)(gbase) + (voff)[_i]), (PG8_LAS unsigned*)(lds + (bufoff) + ldsw + _i * 8192), 16, 0, 0); } while (0)
#define PG8_LDA(dst, b, h) do { _Pragma("unroll") for (int m = 0; m < 4; ++m) _Pragma("unroll") for (int k = 0; k < 2; ++k) dst[m][k] = *(const PG8_LAS bf16x8*)(lds + PG8_SA(b, h) + aoff + m * 2048 + k * 1024); } while (0)
#define PG8_LDB(dst, b, h) do { _Pragma("unroll") for (int n = 0; n < 2; ++n) _Pragma("unroll") for (int k = 0; k < 2; ++k) dst[n][k] = *(const PG8_LAS bf16x8*)(lds + PG8_SB(b, h) + boff + n * 2048 + k * 1024); } while (0)
#define PG8_MMA(ai, bj, At, Bt) do { __builtin_amdgcn_s_setprio(1); _Pragma("unroll") for (int m = 0; m < 4; ++m) _Pragma("unroll") for (int n = 0; n < 2; ++n) _Pragma("unroll") for (int k = 0; k < 2; ++k) \
        acc[ai][bj][m][n] = __builtin_amdgcn_mfma_f32_16x16x32_bf16(Bt[n][k], At[m][k], acc[ai][bj][m][n], 0, 0, 0); __builtin_amdgcn_s_setprio(0); } while (0)
#define PG8_WAIT_V(n) asm volatile("s_waitcnt vmcnt(" #n ")" ::: "memory")
#define PG8_WAIT_L(n) asm volatile("s_waitcnt lgkmcnt(" #n ")" ::: "memory")
#define PG8_BAR __builtin_amdgcn_s_barrier()
#define PG8_SCHED __builtin_amdgcn_sched_barrier(0)
    Unit cur, nxt; int ui = 0;
    if (!S.next(0, cur)) return;
    f32x4 acc[2][2][4][2];
#pragma unroll
    for (int a = 0; a < 2; ++a)
#pragma unroll
        for (int b = 0; b < 2; ++b)
#pragma unroll
            for (int m = 0; m < 4; ++m)
#pragma unroll
                for (int n = 0; n < 2; ++n) acc[a][b][m][n] = (f32x4){0.f, 0.f, 0.f, 0.f};
    bf16x8 At[4][2], B0[2][2], B1[2][2];
    const char* cA = (const char*)g.A + (size_t)cur.pm * tstepA; const char* cB = (const char*)g.Bt + (size_t)cur.pn * tstep;
    S.a_ready(cur);
    if constexpr (SP2) {
        PG8_STAGE(PG8_SB(0, 0), cB, voffB); PG8_STAGE(PG8_SB(0, 1), cB + hstep, voffB); PG8_STAGE(PG8_SA(0, 0), cA, voffA); PG8_STAGE(PG8_SA(0, 1), cA + hstepA, voffA);
        if (wr == 1) PG8_BAR;
        PG8_WAIT_V(2); PG8_BAR;
        PG8_STAGE(PG8_SB(1, 0), cB + kstep, voffB); PG8_STAGE(PG8_SA(1, 0), cA + kstep, voffA); PG8_STAGE(PG8_SB(1, 1), cB + hstep + kstep, voffB);
        PG8_WAIT_V(6); PG8_BAR;
    } else {
        PG8_STAGE(PG8_SB(0, 0), cB, voffB); PG8_STAGE(PG8_SA(0, 0), cA, voffA); PG8_STAGE(PG8_SB(0, 1), cB + hstep, voffB); PG8_STAGE(PG8_SA(0, 1), cA + hstepA, voffA);
        if (wr == 1) PG8_BAR;
        PG8_WAIT_V(4); PG8_BAR;
        PG8_STAGE(PG8_SB(1, 0), cB + kstep, voffB); PG8_STAGE(PG8_SA(1, 0), cA + kstep, voffA); PG8_STAGE(PG8_SB(1, 1), cB + hstep + kstep, voffB);
        PG8_WAIT_V(6); PG8_BAR;
    }
    for (;;) {
        const bool has_next = S.next(ui + 1, nxt);
        const char* nA = has_next ? (const char*)g.A + (size_t)nxt.pm * tstepA : cA; const char* nB = has_next ? (const char*)g.Bt + (size_t)nxt.pn * tstep : cB;
        _Pragma("unroll 1") for (int t = 0; t < nt; t += 2) {
            const bool last = (t == nt - 2);
            const char* a1 = cA + (size_t)(t + 1) * kstep;
            const char* a2 = last ? nA : cA + (size_t)(t + 2) * kstep; const char* b2 = last ? nB : cB + (size_t)(t + 2) * kstep;
            const char* a3 = a2 + kstep; const char* b3 = b2 + kstep;
            if (last && has_next) S.a_ready(nxt);
            if constexpr (SP2) {
            PG8_LDB(B0, 0, 0); PG8_LDB(B1, 0, 1); PG8_SCHED; PG8_LDA(At, 0, 0); PG8_STAGE(PG8_SA(1, 1), a1 + hstepA, voffA);
            PG8_WAIT_V(8); PG8_WAIT_L(0); PG8_BAR; PG8_MMA(0, 0, At, B0); PG8_MMA(0, 1, At, B1); PG8_BAR; PG8_SCHED;
            PG8_LDA(At, 0, 1); PG8_STAGE(PG8_SB(0, 0), b2, voffB); PG8_STAGE(PG8_SB(0, 1), b2 + hstep, voffB); PG8_STAGE(PG8_SA(0, 0), a2, voffA);
            PG8_WAIT_V(8); PG8_WAIT_L(0); PG8_BAR; PG8_MMA(1, 0, At, B0); PG8_MMA(1, 1, At, B1); PG8_BAR; PG8_SCHED;
            PG8_LDB(B0, 1, 0); PG8_LDB(B1, 1, 1); PG8_SCHED; PG8_LDA(At, 1, 0); PG8_STAGE(PG8_SA(0, 1), a2 + hstepA, voffA);
            PG8_WAIT_V(8); PG8_WAIT_L(0); PG8_BAR; PG8_MMA(0, 0, At, B0); PG8_MMA(0, 1, At, B1); PG8_BAR; PG8_SCHED;
            PG8_LDA(At, 1, 1); PG8_STAGE(PG8_SB(1, 0), b3, voffB); PG8_STAGE(PG8_SB(1, 1), b3 + hstep, voffB); PG8_STAGE(PG8_SA(1, 0), a3, voffA);
            PG8_WAIT_V(8); PG8_WAIT_L(0); PG8_BAR; PG8_MMA(1, 0, At, B0); PG8_MMA(1, 1, At, B1); PG8_BAR; PG8_SCHED;
            } else {
            PG8_LDB(B0, 0, 0); PG8_SCHED; PG8_LDA(At, 0, 0); PG8_STAGE(PG8_SA(1, 1), a1 + hstepA, voffA);
            PG8_WAIT_L(8); PG8_BAR; PG8_WAIT_L(0); PG8_MMA(0, 0, At, B0); PG8_BAR; PG8_SCHED;
            PG8_LDB(B1, 0, 1); PG8_STAGE(PG8_SB(0, 0), b2, voffB);
            PG8_BAR; PG8_WAIT_L(0); PG8_MMA(0, 1, At, B1); PG8_BAR;
            PG8_LDA(At, 0, 1); PG8_STAGE(PG8_SA(0, 0), a2, voffA);
            PG8_BAR; PG8_WAIT_L(0); PG8_MMA(1, 0, At, B0); PG8_BAR; PG8_SCHED;
            PG8_STAGE(PG8_SB(0, 1), b2 + hstep, voffB);
            PG8_WAIT_V(6); PG8_BAR; PG8_MMA(1, 1, At, B1); PG8_BAR;
            PG8_LDB(B0, 1, 0); PG8_SCHED; PG8_LDA(At, 1, 0); PG8_STAGE(PG8_SA(0, 1), a2 + hstepA, voffA);
            PG8_WAIT_L(8); PG8_BAR; PG8_WAIT_L(0); PG8_MMA(0, 0, At, B0); PG8_BAR; PG8_SCHED;
            PG8_LDB(B1, 1, 1); PG8_STAGE(PG8_SB(1, 0), b3, voffB);
            PG8_BAR; PG8_WAIT_L(0); PG8_MMA(0, 1, At, B1); PG8_BAR;
            PG8_LDA(At, 1, 1); PG8_STAGE(PG8_SA(1, 0), a3, voffA);
            PG8_BAR; PG8_WAIT_L(0); PG8_MMA(1, 0, At, B0); PG8_BAR; PG8_SCHED;
            PG8_STAGE(PG8_SB(1, 1), b3 + hstep, voffB);
            PG8_WAIT_V(6); PG8_BAR; PG8_MMA(1, 1, At, B1); PG8_BAR;
            }
        }
        if constexpr (ALIGN_EPI) { if (wr == 0) PG8_BAR; }
        if constexpr (!Epi::AFTER_DRAIN) { E(acc, cur, wr, wc, fr, fq); S.done(cur); }
        if (!has_next) break;
#pragma unroll
        for (int a = 0; a < 2; ++a)
#pragma unroll
            for (int b = 0; b < 2; ++b)
#pragma unroll
                for (int m = 0; m < 4; ++m)
#pragma unroll
                    for (int n = 0; n < 2; ++n) acc[a][b][m][n] = (f32x4){0.f, 0.f, 0.f, 0.f};
        cur = nxt; cA = nA; cB = nB; ++ui;
        if constexpr (ALIGN_EPI) { if (wr == 1) PG8_BAR; }
    }
    PG8_WAIT_V(0);
    if constexpr (!ALIGN_EPI) { if (wr == 0) PG8_BAR; }
    PG8_BAR;
    if constexpr (Epi::AFTER_DRAIN) { E.fused(acc, cur, wr, wc, fr, fq, lds, wid, lane); S.done(cur); }
#undef PG8_SA
#undef PG8_SB
#undef PG8_STAGE
#undef PG8_LDA
#undef PG8_LDB
#undef PG8_MMA
#undef PG8_WAIT_V
#undef PG8_WAIT_L
#undef PG8_BAR
#undef PG8_SCHED
}
}

#define LAS __attribute__((address_space(3)))
typedef unsigned short bf16_t;
typedef float f32x4 __attribute__((ext_vector_type(4)));
typedef LAS float lfloat;

constexpr int NB = 4, SEQ = 4096, DM = 1024, MT = NB * SEQ, NL = 2;
constexpr int NIN = 3840, K2 = 384, N2 = 2304, DFF = 2816, NGU = 5632;
#ifndef EXTRA_SYNCS
#define EXTRA_SYNCS 0
#endif
#ifndef SCAN_TWICE
#define SCAN_TWICE 0
#endif
#ifndef XTRA_LDS
#define XTRA_LDS 0
#endif
#ifndef DUPMASK
#define DUPMASK 0
#endif
#ifndef PHMASK
#define PHMASK 0xfff
#endif
constexpr int NPH = 12;
constexpr size_t MiB = 1u << 20;
constexpr size_t OFF_MOD = 0, OFF_DEC = 1 * MiB, OFF_W = 2 * MiB;
constexpr size_t OFF_WIN = OFF_W, OFF_WO = OFF_WIN + (size_t)NIN * DM * 2, OFF_WGU = OFF_WO + (size_t)DM * DM * 2,
                 OFF_WD = OFF_WGU + (size_t)NGU * DM * 2, OFF_W2L = OFF_WD + (size_t)DM * DFF * 2, OFF_WEND = OFF_W2L + (size_t)N2 * K2 * 2;
constexpr size_t OFF_VF = 30 * MiB, OFF_XN = 46 * MiB, OFF_KV = OFF_XN, OFF_YS = OFF_XN + 16 * MiB;
constexpr size_t OFF_ZR = 78 * MiB, OFF_ZG = 126 * MiB, OFF_HFF = OFF_ZR, OFF_PRE = 174 * MiB, OFF_ZX = OFF_PRE, OFF_BND = 246 * MiB, OFF_BON = 250 * MiB, OFF_G16 = 251 * MiB, OFF_END = 253 * MiB;
static_assert(OFF_WEND <= OFF_VF, "weights fit");

struct Args { const float* in[35]; float* out; unsigned char* ws; int ph_lo, ph_hi, coop, pad; };
typedef const __attribute__((address_space(4))) Args CArgs;
__device__ __forceinline__ CArgs* launder_args(CArgs* p) { asm volatile("" : "+s"(p)); return p; }

__device__ __forceinline__ float bf2f(unsigned u16) { return __uint_as_float(u16 << 16); }
__device__ __forceinline__ f32x4 unpack4(uint2 u) { return (f32x4){__uint_as_float(u.x << 16), __uint_as_float(u.x & 0xffff0000u), __uint_as_float(u.y << 16), __uint_as_float(u.y & 0xffff0000u)}; }
typedef unsigned u32x2 __attribute__((ext_vector_type(2)));
__device__ __forceinline__ f32x4 unpack4(u32x2 u) { return (f32x4){__uint_as_float(u[0] << 16), __uint_as_float(u[0] & 0xffff0000u), __uint_as_float(u[1] << 16), __uint_as_float(u[1] & 0xffff0000u)}; }
__device__ __forceinline__ uint2 pack4(f32x4 v) { uint2 r; r.x = pg8::cvt_pk_bf16(v[0], v[1]); r.y = pg8::cvt_pk_bf16(v[2], v[3]); return r; }
__device__ __forceinline__ unsigned short f2bf1(float v) { return (unsigned short)(pg8::cvt_pk_bf16(v, 0.f) & 0xffffu); }
__device__ __forceinline__ float sigmoidf_(float x) { return __builtin_amdgcn_rcpf(1.f + __expf(-x)); }
__device__ __forceinline__ float siluf_(float x) { return x * sigmoidf_(x); }
__device__ __forceinline__ float tanhf_(float x) { return 1.f - 2.f * __builtin_amdgcn_rcpf(__expf(2.f * x) + 1.f); }
__device__ __forceinline__ float softplusf_(float z) { return fmaxf(z, 0.f) + __logf(1.f + __expf(-fabsf(z))); }
__device__ __forceinline__ float row_allreduce16(float v) {
    v += __int_as_float(__builtin_amdgcn_update_dpp(0, __float_as_int(v), 0x128, 0xf, 0xf, false));
    v += __int_as_float(__builtin_amdgcn_update_dpp(0, __float_as_int(v), 0x124, 0xf, 0xf, false));
    v += __int_as_float(__builtin_amdgcn_update_dpp(0, __float_as_int(v), 0x122, 0xf, 0xf, false));
    v += __int_as_float(__builtin_amdgcn_update_dpp(0, __float_as_int(v), 0x121, 0xf, 0xf, false));
    return v;
}
__device__ __forceinline__ float row_allreduce32(float v) {
    v = row_allreduce16(v);
    const auto rr = __builtin_amdgcn_permlane32_swap(__float_as_uint(v), __float_as_uint(v), false, false);
    return __uint_as_float(rr[0]) + __uint_as_float(rr[1]);
}
__device__ __forceinline__ float wave_sum(float v) {
#pragma unroll
    for (int o = 1; o < 64; o <<= 1) v += __shfl_xor(v, o);
    return v;
}
#define LDS_BARRIER() do { asm volatile("s_waitcnt lgkmcnt(0)" ::: "memory"); __builtin_amdgcn_s_barrier(); asm volatile("" ::: "memory"); } while (0)
__device__ __forceinline__ float sum4(f32x4 v) { return (v[0] + v[1]) + (v[2] + v[3]); }

namespace pg8 {
struct EpiIn {
    static constexpr bool PERM = true, AFTER_DRAIN = false;
    bf16_t *ZR, *ZG, *ZX;
    __device__ __forceinline__ void operator()(const f32x4 (&acc)[2][2][4][2], const Unit& u, int wr, int wc, int fr, int fq) const {
        int colt = u.pn * BM; bf16_t* base; int ldc;
        if (colt < 1536) { base = ZR; ldc = 1536; } else if (colt < 3072) { base = ZG; ldc = 1536; colt -= 1536; } else { base = ZX; ldc = 768; colt -= 3072; }
        const int row0 = u.pm * BM + wr * 64 + fr, col0 = colt + wc * 32 + 8 * fq;
#pragma unroll
        for (int ai = 0; ai < 2; ++ai)
#pragma unroll
            for (int m = 0; m < 4; ++m) { bf16_t* rowp = base + (size_t)(row0 + ai * HALF + m * 16) * ldc + col0;
#pragma unroll
                for (int bj = 0; bj < 2; ++bj) { const f32x4 v0 = acc[ai][bj][m][0], v1 = acc[ai][bj][m][1];
                    u32x4 w; w.x = cvt_pk_bf16(v0[0], v0[1]); w.y = cvt_pk_bf16(v0[2], v0[3]); w.z = cvt_pk_bf16(v1[0], v1[1]); w.w = cvt_pk_bf16(v1[2], v1[3]);
                    *(u32x4*)(rowp + bj * HALF) = w; } }
    }
};
struct EpiPlain {
    static constexpr bool PERM = true, AFTER_DRAIN = false;
    bf16_t* O; int ldc;
    __device__ __forceinline__ void operator()(const f32x4 (&acc)[2][2][4][2], const Unit& u, int wr, int wc, int fr, int fq) const {
        const int row0 = u.pm * BM + wr * 64 + fr, col0 = u.pn * BM + wc * 32 + 8 * fq;
#pragma unroll
        for (int ai = 0; ai < 2; ++ai)
#pragma unroll
            for (int m = 0; m < 4; ++m) { bf16_t* rowp = O + (size_t)(row0 + ai * HALF + m * 16) * ldc + col0;
#pragma unroll
                for (int bj = 0; bj < 2; ++bj) { const f32x4 v0 = acc[ai][bj][m][0], v1 = acc[ai][bj][m][1];
                    u32x4 w; w.x = cvt_pk_bf16(v0[0], v0[1]); w.y = cvt_pk_bf16(v0[2], v0[3]); w.z = cvt_pk_bf16(v1[0], v1[1]); w.w = cvt_pk_bf16(v1[2], v1[3]);
                    *(u32x4*)(rowp + bj * HALF) = w; } }
    }
};
struct EpiRes {
    static constexpr bool PERM = true, AFTER_DRAIN = false;
    const float* xin; float* xout; const float* gate;
    __device__ __forceinline__ void operator()(const f32x4 (&acc)[2][2][4][2], const Unit& u, int wr, int wc, int fr, int fq) const {
        const int b = u.pm >> 4; const float* gp = gate + b * 6144;
        const int row0 = u.pm * BM + wr * 64 + fr, col0 = u.pn * BM + wc * 32 + 8 * fq;
        f32x4 gv[2][2];
#pragma unroll
        for (int bj = 0; bj < 2; ++bj)
#pragma unroll
            for (int n = 0; n < 2; ++n) gv[bj][n] = *(const f32x4*)(gp + col0 + bj * HALF + 4 * n);
#pragma unroll
        for (int ai = 0; ai < 2; ++ai)
#pragma unroll
            for (int m = 0; m < 4; ++m) { const size_t off = (size_t)(row0 + ai * HALF + m * 16) * 1024 + col0;
#pragma unroll
                for (int bj = 0; bj < 2; ++bj)
#pragma unroll
                    for (int n = 0; n < 2; ++n) { const f32x4 xi = *(const f32x4*)(xin + off + bj * HALF + 4 * n);
                        *(f32x4*)(xout + off + bj * HALF + 4 * n) = xi + gv[bj][n] * acc[ai][bj][m][n]; } }
    }
};
struct EpiSwiGLU {
    static constexpr bool PERM = true, AFTER_DRAIN = false;
    bf16_t* H;
    __device__ __forceinline__ void operator()(const f32x4 (&acc)[2][2][4][2], const Unit& u, int wr, int wc, int fr, int fq) const {
        const int row0 = u.pm * BM + wr * 64 + fr, col0 = u.pn * HALF + wc * 32 + 8 * fq;
#pragma unroll
        for (int ai = 0; ai < 2; ++ai)
#pragma unroll
            for (int m = 0; m < 4; ++m) { bf16_t* rowp = H + (size_t)(row0 + ai * HALF + m * 16) * DFF + col0;
                f32x4 g0 = acc[ai][0][m][0], g1 = acc[ai][0][m][1]; const f32x4 u0 = acc[ai][1][m][0], u1 = acc[ai][1][m][1];
#pragma unroll
                for (int i = 0; i < 4; ++i) { g0[i] = siluf_(g0[i]) * u0[i]; g1[i] = siluf_(g1[i]) * u1[i]; }
                u32x4 w; w.x = cvt_pk_bf16(g0[0], g0[1]); w.y = cvt_pk_bf16(g0[2], g0[3]); w.z = cvt_pk_bf16(g1[0], g1[1]); w.w = cvt_pk_bf16(g1[2], g1[3]);
                *(u32x4*)rowp = w; }
    }
};
}

template <class F> __device__ __forceinline__ void prep_mat(bf16_t* dst, int NR, int K, int gtid, int gthreads, F src) {
    const int total = NR * (K >> 3);
    for (int i = gtid; i < total; i += gthreads) { const int n = i % NR, kb = i / NR; float v[8];
#pragma unroll
        for (int j = 0; j < 8; ++j) v[j] = src(n, kb * 8 + j);
        uint4 o; o.x = pg8::cvt_pk_bf16(v[0], v[1]); o.y = pg8::cvt_pk_bf16(v[2], v[3]); o.z = pg8::cvt_pk_bf16(v[4], v[5]); o.w = pg8::cvt_pk_bf16(v[6], v[7]);
        *(uint4*)(dst + (size_t)n * K + kb * 8) = o; }
}
template <class F, class R> __device__ __forceinline__ void prep_mat_rm(bf16_t* dst, int NR, int K, int gtid, int gthreads, F src, R rowmap) {
    const int total = NR * (K >> 3);
    for (int i = gtid; i < total; i += gthreads) { const int n = i % NR, kb = i / NR; float v[8];
#pragma unroll
        for (int j = 0; j < 8; ++j) v[j] = src(n, kb * 8 + j);
        uint4 o; o.x = pg8::cvt_pk_bf16(v[0], v[1]); o.y = pg8::cvt_pk_bf16(v[2], v[3]); o.z = pg8::cvt_pk_bf16(v[4], v[5]); o.w = pg8::cvt_pk_bf16(v[6], v[7]);
        *(uint4*)(dst + (size_t)rowmap(n) * K + kb * 8) = o; }
}
__device__ __forceinline__ void transpose_item(const float* W  , int ldw, bf16_t* WT  , int K, lfloat* scr, int lane) {
#pragma unroll 8
    for (int i = 0; i < 32; ++i) { const int kk = 2 * i + (lane >> 5); scr[kk * 33 + (lane & 31)] = W[(size_t)kk * ldw + (lane & 31)]; }
    asm volatile("s_waitcnt lgkmcnt(0)" ::: "memory");
    const int c = lane & 7;
#pragma unroll
    for (int jj = 0; jj < 4; ++jj) { const int n = (lane >> 3) + 8 * jj; const lfloat* p = scr + (8 * c) * 33 + n;
        uint4 o; o.x = pg8::cvt_pk_bf16(p[0], p[33]); o.y = pg8::cvt_pk_bf16(p[66], p[99]); o.z = pg8::cvt_pk_bf16(p[132], p[165]); o.w = pg8::cvt_pk_bf16(p[198], p[231]);
        *(uint4*)(WT + (size_t)n * K + 8 * c) = o; }
    asm volatile("s_waitcnt lgkmcnt(0)" ::: "memory");
}
__device__ __forceinline__ void phase_weights_tiled(CArgs* ap, int l, lfloat* lds) {
    const int tid = ltid(), lane = tid & 63, wave = tid >> 6; lfloat* scr = lds + wave * 2176;
    const int gw = lbid() * 8 + wave, ngw = gridDim.x * 8; unsigned char* ws = ap->ws;
    constexpr int I_IN = 16 * 96, I_O = 16 * 32, I_G = 16 * 88, I_D = 44 * 32, NIT = I_IN + I_O + 2 * I_G + I_D;
    for (int it = gw; it < NIT; it += ngw) { CArgs& a = *launder_args(ap); int r = it;
        if (r < I_IN) { const int kb = r / 96, nb = r % 96; transpose_item(a.in[6] + (size_t)l * DM * 3072 + (size_t)(kb * 64) * 3072 + nb * 32, 3072, (bf16_t*)(ws + OFF_WIN) + (size_t)(nb * 32) * DM + kb * 64, DM, scr, lane); continue; } r -= I_IN;
        if (r < I_O) { const int kb = r / 32, nb = r % 32; const int ks = (kb * 64 + 512) & 1023;
            transpose_item(a.in[7] + (size_t)l * DM * DM + (size_t)ks * DM + nb * 32, DM, (bf16_t*)(ws + OFF_WO) + (size_t)(nb * 32) * DM + kb * 64, DM, scr, lane); continue; } r -= I_O;
        if (r < 2 * I_G) { const int up = r >= I_G; if (up) r -= I_G; const int kb = r / 88, nb = r % 88, n0 = nb * 32; const int row0 = (n0 >> 7) * 256 + (n0 & 127) + (up ? 128 : 0);
            const float* W = (up ? a.in[32] : a.in[31]) + (size_t)l * DM * DFF;
            transpose_item(W + (size_t)(kb * 64) * DFF + n0, DFF, (bf16_t*)(ws + OFF_WGU) + (size_t)row0 * DM + kb * 64, DM, scr, lane); continue; } r -= 2 * I_G;
        { const int kb = r / 32, nb = r % 32; transpose_item(a.in[33] + (size_t)l * DFF * DM + (size_t)(kb * 64) * DM + nb * 32, DM, (bf16_t*)(ws + OFF_WD) + (size_t)(nb * 32) * DFF + kb * 64, DFF, scr, lane); }
    }
}
__device__ __forceinline__ void phase_weights(CArgs* ap, int l) {
    const int gtid = lbid() * 512 + ltid(), gth = gridDim.x * 512;
    unsigned char* ws = ap->ws;
    {   CArgs& a = *launder_args(ap);
        const float* mux = a.in[9] + (size_t)l * 3 * DM; const float* w1 = a.in[11] + (size_t)l * DM * 64; const float* a1 = a.in[14] + (size_t)l * DM * 64;
        const float* g1 = a.in[16] + (size_t)l * DM * 128; const float* muv = a.in[23]; const float* v1 = a.in[25]; const float* ga1 = a.in[27] + (size_t)l * DM * 16;
        prep_mat((bf16_t*)(ws + OFF_WIN) + (size_t)3072 * DM, 768, DM, gtid, gth, [=](int n, int k) -> float {
            if (n < 128) { const float mu = mux[k]; const int j = n & 63; return (n < 64 ? 1.f - mu : mu) * w1[k * 64 + j]; }
            if (n < 256) { const float mu = mux[DM + k]; const int j = n & 63; return (n < 192 ? 1.f - mu : mu) * a1[k * 64 + j]; }
            if (n < 512) { const float mu = mux[2 * DM + k]; const int j = n & 127; return (n < 384 ? 1.f - mu : mu) * g1[k * 128 + j]; }
            if (n < 576) { if (l == 0) return 0.f; const float mu = muv[k]; const int j = n & 31; return (n < 544 ? 1.f - mu : mu) * v1[k * 32 + j]; }
            if (n < 592) return ga1[k * 16 + (n - 576)];
            return 0.f; });
    }
    {   CArgs& a = *launder_args(ap);
        const float* w2 = a.in[12] + (size_t)l * 64 * 512; const float* a2 = a.in[15] + (size_t)l * 64 * 512; const float* g2 = a.in[17] + (size_t)l * 128 * 512;
        const float* v2 = a.in[26]; const float* ga2 = a.in[28] + (size_t)l * 16 * 128;
        prep_mat((bf16_t*)(ws + OFF_W2L), N2, K2, gtid, gth, [=](int n, int k) -> float {
            if (n < 512) return k < 64 ? w2[k * 512 + n] : 0.f;
            if (n < 1024) return (k >= 64 && k < 128) ? a2[(k - 64) * 512 + (n - 512)] : 0.f;
            if (n < 1536) return (k >= 128 && k < 256) ? g2[(k - 128) * 512 + (n - 1024)] : 0.f;
            if (n < 2048) return (l == 1 && k >= 256 && k < 288) ? v2[(k - 256) * 512 + (n - 1536)] : 0.f;
            if (n < 2176) return (k >= 288 && k < 304) ? ga2[(k - 288) * 128 + (n - 2048)] : 0.f;
            return 0.f; });
    }
}
__device__ __forceinline__ void phase_adaln(CArgs& a, lfloat* lds) {
    const int tid = ltid(); lfloat* sc = lds; lfloat* part = lds + 4096;
    for (int i = tid; i < 4096; i += 512) sc[i] = siluf_(a.in[1][i]);
    __syncthreads();
    float* mod = (float*)(a.ws + OFF_MOD);
    for (int item = lbid(); item < 2 * 192; item += gridDim.x) {
        const int l = item / 192, col0 = (item % 192) * 32, col = tid & 31, kg = tid >> 5;
        const float* W = a.in[2] + (size_t)l * DM * 6144 + col0 + col;
        float acc0 = 0.f, acc1 = 0.f, acc2 = 0.f, acc3 = 0.f;
#pragma unroll 8
        for (int kk = 0; kk < 64; ++kk) { const int k = kg * 64 + kk; const float w = W[(size_t)k * 6144];
            acc0 += sc[k] * w; acc1 += sc[1024 + k] * w; acc2 += sc[2048 + k] * w; acc3 += sc[3072 + k] * w; }
        part[(kg * 4 + 0) * 32 + col] = acc0; part[(kg * 4 + 1) * 32 + col] = acc1; part[(kg * 4 + 2) * 32 + col] = acc2; part[(kg * 4 + 3) * 32 + col] = acc3;
        __syncthreads();
        if (tid < 128) { const int b = tid >> 5; float s = a.in[3][l * 6144 + col0 + col];
#pragma unroll
            for (int g = 0; g < 16; ++g) s += part[(g * 4 + b) * 32 + col];
            mod[(l * 4 + b) * 6144 + col0 + col] = s; }
        __syncthreads();
    }
}
__device__ __forceinline__ void phase_modnorm(const float* X, const float* g, const float* mod  , int sh_off, bf16_t* out) {
    const int lane = ltid() & 63, gw = lbid() * 8 + (ltid() >> 6), ngw = gridDim.x * 8;
    for (int m = gw; m < MT; m += ngw) {
        const f32x4* xr = (const f32x4*)(X + (size_t)m * DM) + lane; f32x4 v[4]; float s = 0.f;
#pragma unroll
        for (int j = 0; j < 4; ++j) { v[j] = xr[64 * j]; s += sum4(v[j] * v[j]); }
        const float rstd = rsqrtf(wave_sum(s) * (1.f / DM) + 1e-6f);
        const float* mp = mod + (m >> 12) * 6144 + sh_off;
        uint2* o = (uint2*)(out + (size_t)m * DM) + lane;
#pragma unroll
        for (int j = 0; j < 4; ++j) { const int c = 4 * lane + 256 * j; const f32x4 gg = *(const f32x4*)(g + c), sh = *(const f32x4*)(mp + c), sc = *(const f32x4*)(mp + 1024 + c);
            o[64 * j] = pack4(v[j] * rstd * gg * (1.f + sc) + sh); }
    }
}
__device__ __forceinline__ void phase_finalnorm(float* X, const float* g) {
    const int lane = ltid() & 63, gw = lbid() * 8 + (ltid() >> 6), ngw = gridDim.x * 8;
    for (int m = gw; m < MT; m += ngw) {
        f32x4* xr = (f32x4*)(X + (size_t)m * DM) + lane; f32x4 v[4]; float s = 0.f;
#pragma unroll
        for (int j = 0; j < 4; ++j) { v[j] = xr[64 * j]; s += sum4(v[j] * v[j]); }
        const float rstd = rsqrtf(wave_sum(s) * (1.f / DM) + 1e-6f);
#pragma unroll
        for (int j = 0; j < 4; ++j) { const int c = 4 * lane + 256 * j; xr[64 * j] = v[j] * rstd * *(const f32x4*)(g + c); }
    }
}
__device__ __forceinline__ void load8(const bf16_t* p, float (&v)[8]) { const uint4 u = *(const uint4*)p;
    v[0] = __uint_as_float(u.x << 16); v[1] = __uint_as_float(u.x & 0xffff0000u); v[2] = __uint_as_float(u.y << 16); v[3] = __uint_as_float(u.y & 0xffff0000u);
    v[4] = __uint_as_float(u.z << 16); v[5] = __uint_as_float(u.z & 0xffff0000u); v[6] = __uint_as_float(u.w << 16); v[7] = __uint_as_float(u.w & 0xffff0000u); }
__device__ __forceinline__ void store8(bf16_t* p, const float (&v)[8]) { uint4 o; o.x = pg8::cvt_pk_bf16(v[0], v[1]); o.y = pg8::cvt_pk_bf16(v[2], v[3]); o.z = pg8::cvt_pk_bf16(v[4], v[5]); o.w = pg8::cvt_pk_bf16(v[6], v[7]); *(uint4*)p = o; }
__device__ __forceinline__ void phase_loramid(const bf16_t* ZX, bf16_t* A2, const bf16_t* ZR, bf16_t* BND) {
    const int gtid = lbid() * 512 + ltid(), gth = gridDim.x * 512;
    for (int i = gtid; i < 1024 * 192; i += gth) { const int row = i / 192, q8 = (i % 192) * 8;
        *(uint4*)(BND + (size_t)row * 1536 + q8) = *(const uint4*)(ZR + (size_t)(row * 16 + 15) * 1536 + q8); }
    for (int i = gtid; i < MT * 48; i += gth) { const int m = i / 48, cg = i % 48, c = cg * 8, t = m & (SEQ - 1);
        const bf16_t* zr = ZX + (size_t)m * 768; float p[8], q[8], o[8];
        int pc, qc, mode;
        if (c < 64) { pc = c; qc = 64 + c; mode = 0; } else if (c < 128) { pc = 128 + (c - 64); qc = 192 + (c - 64); mode = 1; }
        else if (c < 256) { pc = 256 + (c - 128); qc = 384 + (c - 128); mode = 2; } else if (c < 288) { pc = 512 + (c - 256); qc = 544 + (c - 256); mode = 1; }
        else if (c < 304) { pc = 576 + (c - 288); qc = 0; mode = 3; } else { pc = 0; qc = 0; mode = 4; }
        if (mode == 4) {
#pragma unroll
            for (int j = 0; j < 8; ++j) o[j] = 0.f;
        } else {
            load8(zr + pc, p);
            if (mode != 3 && t > 0) load8(zr - 768 + qc, q); else {
#pragma unroll
                for (int j = 0; j < 8; ++j) q[j] = 0.f; }
#pragma unroll
            for (int j = 0; j < 8; ++j) { const float s = p[j] + q[j]; o[j] = mode == 0 ? tanhf_(s) : (mode == 2 ? sigmoidf_(s) : s); }
        }
        store8(A2 + (size_t)m * K2 + c, o); }
}
struct RwConst { f32x4 mu_r, mu_k, mu_v, k_k, k_a, w0, a0, v0; };
__device__ __forceinline__ RwConst rw_load_const(CArgs& a, int l, int c) {
    RwConst k; const float* mu = a.in[8] + (size_t)l * 3 * 512;
    k.mu_r = *(const f32x4*)(mu + c); k.mu_k = *(const f32x4*)(mu + 512 + c); k.mu_v = *(const f32x4*)(mu + 1024 + c);
    k.k_k = *(const f32x4*)(a.in[18] + l * 512 + c); k.k_a = *(const f32x4*)(a.in[19] + l * 512 + c);
    k.w0 = *(const f32x4*)(a.in[10] + l * 512 + c); k.a0 = *(const f32x4*)(a.in[13] + l * 512 + c);
    k.v0 = l ? *(const f32x4*)(a.in[24] + c) : (f32x4){0.f, 0.f, 0.f, 0.f};
    return k;
}
struct RwTok { uint2 r, k, v, wpre, apre, vgpre, vf; };
__device__ __forceinline__ RwTok rw_load_tok(const bf16_t* ZR, const bf16_t* PRE, const bf16_t* VF, int l, int m, int c) {
    RwTok x; const uint2 z = {0u, 0u};
    const uint2* zr = (const uint2*)(ZR + (size_t)m * 1536 + c); x.r = zr[0]; x.k = zr[128]; x.v = zr[256];
    const uint2* pr = (const uint2*)(PRE + (size_t)m * N2 + c); x.wpre = pr[0]; x.apre = pr[128];
    if (l) { x.vgpre = pr[384]; x.vf = *(const uint2*)(VF + (size_t)m * 512 + c); } else { x.vgpre = z; x.vf = z; }
    return x;
}
__device__ __forceinline__ void phase_rwkv_prep(CArgs& a, int l) {
    bf16_t* ZR = (bf16_t*)(a.ws + OFF_ZR); bf16_t* PRE = (bf16_t*)(a.ws + OFF_PRE); bf16_t* VF = (bf16_t*)(a.ws + OFF_VF); const bf16_t* BND = (const bf16_t*)(a.ws + OFF_BND);
    float* BON = (float*)(a.ws + OFF_BON); float* G16 = (float*)(a.ws + OFF_G16);
    const int g16 = (lbid() * 512 + ltid()) >> 4, ng16 = gridDim.x * 32, j = ltid() & 15;
    for (int g = g16; g < 8192; g += ng16) { const int hd = g & 7, run = g >> 3, c = hd * 64 + 4 * j, mbeg = run * 16;
        const RwConst k = rw_load_const(a, l, c); const f32x4 rk = *(const f32x4*)(a.in[20] + l * 512 + c);
        uint2 rp = {0u, 0u}, kp = rp, vp = rp;
        if (mbeg & (SEQ - 1)) { const uint2* bp = (const uint2*)(BND + (size_t)(run - 1) * 1536 + c); rp = bp[0]; kp = bp[128]; vp = bp[256]; }
        RwTok cur = rw_load_tok(ZR, PRE, VF, l, mbeg, c);
        f32x4 gam = {1.f, 1.f, 1.f, 1.f};
        for (int i = 0; i < 16; ++i) { const int m = mbeg + i;
            RwTok nxt = cur; if (i < 15) nxt = rw_load_tok(ZR, PRE, VF, l, m + 1, c);
            f32x4 r = unpack4(cur.r), kq = unpack4(cur.k), v = unpack4(cur.v);
            r = r + (unpack4(rp) - r) * k.mu_r; kq = kq + (unpack4(kp) - kq) * k.mu_k; v = v + (unpack4(vp) - v) * k.mu_v;
            const f32x4 apre = k.a0 + unpack4(cur.apre), wv = k.w0 + unpack4(cur.wpre); f32x4 av, w;
#pragma unroll
            for (int q = 0; q < 4; ++q) { av[q] = sigmoidf_(apre[q]); w[q] = __expf(-__expf(-softplusf_(-wv[q]) - 0.5f)); }
            const f32x4 kkv = kq * k.k_k; const float ss = row_allreduce16(sum4(kkv * kkv));
            const float inv = 1.f / fmaxf(sqrtf(ss), 1e-12f);
            const f32x4 kk = kkv * inv, kx = kq * (1.f + (av - 1.f) * k.k_a);
            if (l) { const f32x4 vg = k.v0 + unpack4(cur.vgpre), vf = unpack4(cur.vf);
#pragma unroll
                for (int q = 0; q < 4; ++q) v[q] = v[q] + (vf[q] - v[q]) * sigmoidf_(vg[q]); }
            const float bonus = row_allreduce16(sum4(r * kx * rk));
            const f32x4 khat = kk * gam; gam = gam * w;
            f32x4 ginv;
#pragma unroll
            for (int q = 0; q < 4; ++q) ginv[q] = 1.f / gam[q];
            uint2* zr = (uint2*)(ZR + (size_t)m * 1536 + c); uint2* pr = (uint2*)(PRE + (size_t)m * N2 + c);
            zr[0] = pack4(r * gam); zr[128] = pack4(kx * ginv); const uint2 vpk = pack4(v); zr[256] = vpk;
            pr[128] = pack4(khat); pr[384] = pack4(kk * av * ginv);
            if (l == 0) *(uint2*)(VF + (size_t)m * 512 + c) = vpk;
            if (j == 0) BON[(size_t)m * 8 + hd] = bonus;
            rp = cur.r; kp = cur.k; vp = cur.v; cur = nxt; }
        *(f32x4*)(G16 + ((size_t)run * 8 + hd) * 64 + 4 * j) = gam;
    }
}
constexpr int GL_BC = 0, GL_QA = 2048, GL_QB = GL_QA + 2112, GL_QC = GL_QB + 2112, GL_KA = GL_QC + 2112, GL_KB = GL_KA + 2112, GL_KT = GL_KB + 2112,
              GL_V = GL_KT + 2112, GL_SP = GL_V + 4096, GL_ATT = GL_SP + 2048, GL_END = GL_ATT + 64 * 65;
static_assert(GL_END * 4 <= 131072, "GLA/RET LDS");
__device__ __forceinline__ float ret_log2gamma(int h) { return __log2f(1.f - exp2f(-5.f - (float)h)); }
__device__ __forceinline__ void glaret_setup(CArgs& a, int l, int type, int b, int h, int c, lfloat* lds) {
    const int tid = ltid(); const int m0 = b * SEQ + c * 64;
    const bf16_t* ZG = (const bf16_t*)(a.ws + OFF_ZG); const bf16_t* PRE = (const bf16_t*)(a.ws + OFF_PRE);
    lfloat* bc = lds + GL_BC;
    if (type == 0) {
        { const int t = tid >> 3, d4 = (tid & 7) * 4; const f32x4 x = unpack4(*(const uint2*)(PRE + (size_t)(m0 + t) * N2 + 2048 + h * 32 + d4)) + *(const f32x4*)(a.in[29] + l * 128 + h * 32 + d4);
#pragma unroll
          for (int i = 0; i < 4; ++i) bc[t * 32 + d4 + i] = -softplusf_(-x[i]) * (1.f / 16.f); }
        __syncthreads();
        {
            lfloat* seg = lds + GL_ATT; const int d = tid & 31, sg = tid >> 5;
            float v0 = bc[(sg * 4 + 0) * 32 + d], v1 = v0 + bc[(sg * 4 + 1) * 32 + d], v2 = v1 + bc[(sg * 4 + 2) * 32 + d], v3 = v2 + bc[(sg * 4 + 3) * 32 + d];
            seg[sg * 32 + d] = v3;
            __syncthreads();
            float off = 0.f;
#pragma unroll
            for (int q = 0; q < 15; ++q) off += (q < sg) ? seg[q * 32 + d] : 0.f;
            bc[(sg * 4 + 0) * 32 + d] = v0 + off; bc[(sg * 4 + 1) * 32 + d] = v1 + off; bc[(sg * 4 + 2) * 32 + d] = v2 + off; bc[(sg * 4 + 3) * 32 + d] = v3 + off;
        }
        __syncthreads();
    }
    const float scl = 0.17677669529663687f;
    {
        const int t = tid >> 3, i0 = (tid & 7) * 2; const int qoff = type ? 768 : 0, koff = type ? 896 : 128;
        const bf16_t* zr = ZG + (size_t)(m0 + t) * 1536 + h * 32 + i0;
        const unsigned q1u = *(const unsigned*)(zr + qoff), q2u = *(const unsigned*)(zr + qoff + 16), k1u = *(const unsigned*)(zr + koff), k2u = *(const unsigned*)(zr + koff + 16);
        const float l2g = ret_log2gamma(h);
#pragma unroll
        for (int u = 0; u < 2; ++u) { const int i = i0 + u;
            const float q1 = u ? __uint_as_float(q1u & 0xffff0000u) : __uint_as_float(q1u << 16), q2 = u ? __uint_as_float(q2u & 0xffff0000u) : __uint_as_float(q2u << 16);
            const float k1 = u ? __uint_as_float(k1u & 0xffff0000u) : __uint_as_float(k1u << 16), k2 = u ? __uint_as_float(k2u & 0xffff0000u) : __uint_as_float(k2u << 16);
            const int o1 = t * 33 + i, o2 = t * 33 + i + 16;
            if (type == 0) {
                const float b1 = bc[t * 32 + i], b2 = bc[t * 32 + i + 16], e1 = bc[63 * 32 + i], e2 = bc[63 * 32 + i + 16];
                const float p1 = __expf(b1), m1 = __expf(-b1), p2 = __expf(b2), m2 = __expf(-b2);
                lds[GL_QA + o1] = q1 * scl * p1; lds[GL_QB + o1] = q1 * scl * m1; lds[GL_QC + o1] = q1 * scl * p1; lds[GL_KA + o1] = k1 * m1; lds[GL_KB + o1] = k1 * p1; lds[GL_KT + o1] = k1 * __expf(e1 - b1);
                lds[GL_QA + o2] = q2 * scl * p2; lds[GL_QB + o2] = q2 * scl * m2; lds[GL_QC + o2] = q2 * scl * p2; lds[GL_KA + o2] = k2 * m2; lds[GL_KB + o2] = k2 * p2; lds[GL_KT + o2] = k2 * __expf(e2 - b2);
            } else {
                const float invf = exp2f(-(float)i * 0.8304820237218406f);
                const float ang = (float)(c * 64 + t) * invf; const float nr = rintf(ang * 0.15915494309189535f);
                float rr = fmaf(-nr, 6.28125f, ang); rr = fmaf(-nr, 1.9353071795864769e-3f, rr);
                const float cs = __cosf(rr), sn = __sinf(rr);
                const float qr1 = q1 * cs - q2 * sn, qr2 = q2 * cs + q1 * sn, kr1 = k1 * cs - k2 * sn, kr2 = k2 * cs + k1 * sn;
                const float gq = exp2f(l2g * (float)(t + 1)), gk = exp2f(l2g * (float)(63 - t));
                lds[GL_QA + o1] = qr1 * scl; lds[GL_QB + o1] = qr1 * scl; lds[GL_QC + o1] = qr1 * scl * gq; lds[GL_KA + o1] = kr1; lds[GL_KB + o1] = kr1; lds[GL_KT + o1] = kr1 * gk;
                lds[GL_QA + o2] = qr2 * scl; lds[GL_QB + o2] = qr2 * scl; lds[GL_QC + o2] = qr2 * scl * gq; lds[GL_KA + o2] = kr2; lds[GL_KB + o2] = kr2; lds[GL_KT + o2] = kr2 * gk;
            } }
    }
    {
        const int t = tid >> 3, e8 = (tid & 7) * 8; float v[8]; load8(ZG + (size_t)(m0 + t) * 1536 + (type ? 1024 : 256) + h * 64 + e8, v);
#pragma unroll
        for (int i = 0; i < 8; ++i) lds[GL_V + t * 64 + e8 + i] = v[i];
    }
    __syncthreads();
}
__device__ __forceinline__ void phase_glaret_kv(CArgs& a, int l, lfloat* lds) {
    const int tid = ltid(); float* KV = (float*)(a.ws + OFF_KV); float* DEC = (float*)(a.ws + OFF_DEC);
    for (int uid = lbid(); uid < 2048; uid += gridDim.x) {
        const int type = uid >> 10, bh = (uid >> 6) & 15, c = uid & 63, b = bh >> 2, h = bh & 3;
        glaret_setup(a, l, type, b, h, c, lds);
        const int d = tid >> 4, e4 = (tid & 15) * 4; f32x4 acc = {0.f, 0.f, 0.f, 0.f};
#pragma unroll 8
        for (int t = 0; t < 64; ++t) acc += lds[GL_KT + t * 33 + d] * *(const LAS f32x4*)(lds + GL_V + t * 64 + e4);
        *(f32x4*)(KV + ((size_t)((type * 16 + bh) * 64 + c)) * 2048 + d * 64 + e4) = acc;
        if (type == 0 && tid < 32) DEC[(bh * 64 + c) * 32 + tid] = __expf(lds[GL_BC + 63 * 32 + tid]);
        __syncthreads();
    }
}
__device__ __forceinline__ void phase_glaret_out(CArgs& a, int l, lfloat* lds) {
    const int tid = ltid(); const float* KV = (const float*)(a.ws + OFF_KV);
    const bf16_t* ZG = (const bf16_t*)(a.ws + OFF_ZG); bf16_t* PRE = (bf16_t*)(a.ws + OFF_PRE);
    for (int uid = lbid(); uid < 2048; uid += gridDim.x) {
        const int type = uid >> 10, bh = (uid >> 6) & 15, c = uid & 63, b = bh >> 2, h = bh & 3; const int m0 = b * SEQ + c * 64;
        { const f32x4 s = *(const f32x4*)(KV + ((size_t)((type * 16 + bh) * 64 + c)) * 2048 + tid * 4); *(LAS f32x4*)(lds + GL_SP + tid * 4) = s; }
        glaret_setup(a, l, type, b, h, c, lds);
        const int n = tid >> 3, g8 = (tid & 7) * 8;
        {
            float acc[8];
#pragma unroll
            for (int i = 0; i < 8; ++i) acc[i] = 0.f;
            for (int d = 0; d < 32; ++d) { const float qa = lds[GL_QA + n * 33 + d], qb = lds[GL_QB + n * 33 + d];
#pragma unroll
                for (int i = 0; i < 8; ++i) { const int m = g8 + i; acc[i] += (m <= n) ? qa * lds[GL_KA + m * 33 + d] : qb * lds[GL_KB + m * 33 + d]; } }
            const float l2g = ret_log2gamma(h);
#pragma unroll
            for (int i = 0; i < 8; ++i) { const int m = g8 + i; const float pm = type ? exp2f(l2g * (float)(m > n ? m - n : n - m)) : 1.f; lds[GL_ATT + n * 65 + m] = acc[i] * pm; }
        }
        __syncthreads();
        f32x4 o0 = {0.f, 0.f, 0.f, 0.f}, o1 = {0.f, 0.f, 0.f, 0.f};
#pragma unroll 4
        for (int m = 0; m < 64; ++m) { const float w = lds[GL_ATT + n * 65 + m]; o0 += w * *(const LAS f32x4*)(lds + GL_V + m * 64 + g8); o1 += w * *(const LAS f32x4*)(lds + GL_V + m * 64 + g8 + 4); }
#pragma unroll 4
        for (int d = 0; d < 32; ++d) { const float w = lds[GL_QC + n * 33 + d]; o0 += w * *(const LAS f32x4*)(lds + GL_SP + d * 64 + g8); o1 += w * *(const LAS f32x4*)(lds + GL_SP + d * 64 + g8 + 4); }
        float s1 = sum4(o0) + sum4(o1); s1 += __shfl_xor(s1, 1); s1 += __shfl_xor(s1, 2); s1 += __shfl_xor(s1, 4);
        const float mean = type ? s1 * (1.f / 64.f) : 0.f;
        o0 = o0 - mean; o1 = o1 - mean;
        float s2 = sum4(o0 * o0) + sum4(o1 * o1); s2 += __shfl_xor(s2, 1); s2 += __shfl_xor(s2, 2); s2 += __shfl_xor(s2, 4);
        const float rs = rsqrtf(s2 * (1.f / 64.f) + 1e-6f);
        o0 = o0 * rs; o1 = o1 * rs;
        if (type == 0) { const float* lg = a.in[30] + l * 64 + g8; o0 = o0 * *(const f32x4*)lg; o1 = o1 * *(const f32x4*)(lg + 4); }
        float gt[8]; load8(ZG + (size_t)(m0 + n) * 1536 + (type ? 1280 : 512) + h * 64 + g8, gt);
        float ov[8];
#pragma unroll
        for (int i = 0; i < 4; ++i) { ov[i] = o0[i] * siluf_(gt[i]); ov[4 + i] = o1[i] * siluf_(gt[4 + i]); }
        store8(PRE + (size_t)(m0 + n) * N2 + type * 256 + h * 64 + g8, ov);
        __syncthreads();
    }
}
__device__ __forceinline__ void phase_rwkv_out(CArgs& a, int l) {
    const bf16_t* ZR = (const bf16_t*)(a.ws + OFF_ZR); bf16_t* PRE = (bf16_t*)(a.ws + OFF_PRE); const bf16_t* YS = (const bf16_t*)(a.ws + OFF_YS); const float* BON = (const float*)(a.ws + OFF_BON);
    const int g16 = (lbid() * 512 + ltid()) >> 4, ng16 = gridDim.x * 32, j = ltid() & 15;
    for (int it = g16; it < MT * 8; it += ng16) { const int m = it >> 3, hd = it & 7, c = hd * 64 + 4 * j;
        const f32x4 v = unpack4(*(const uint2*)(ZR + (size_t)m * 1536 + 1024 + c));
        const f32x4 g4 = unpack4(*(const uint2*)(PRE + (size_t)m * N2 + 1024 + c));
        const f32x4 y4 = unpack4(*(const uint2*)(YS + (size_t)m * 512 + c));
        const float bonus = BON[(size_t)m * 8 + hd];
        const float mean = row_allreduce16(sum4(y4)) * (1.f / 64.f); const f32x4 yc = y4 - mean;
        const float var = row_allreduce16(sum4(yc * yc)) * (1.f / 64.f); const float rs = rsqrtf(var + 64e-5f);
        const f32x4 lg = *(const f32x4*)(a.in[21] + l * 512 + c), lb = *(const f32x4*)(a.in[22] + l * 512 + c);
        const f32x4 res = (yc * rs * lg + lb + bonus * v) * g4;
        *(uint2*)(PRE + (size_t)m * N2 + 512 + c) = pack4(res);
    }
}
__device__ __forceinline__ void phase_scan(CArgs& a, int l, lfloat* lds, bool do_chunks) {
    const int tid = ltid(), bid = lbid();
    {
        const int gid = bid * 512 + tid;
        if (do_chunks && gid < 65536) { const int type = gid >> 15, r = gid & 32767, bh = r >> 11, elem = r & 2047, d = elem >> 6, h = bh & 3;
            float* base = (float*)(a.ws + OFF_KV) + ((size_t)((type * 16 + bh) * 64)) * 2048 + elem; const float* dec = (const float*)(a.ws + OFF_DEC) + (size_t)(bh * 64) * 32 + d;
            const float rdec = exp2f(ret_log2gamma(h) * 64.f); float s = 0.f;
            for (int c0 = 0; c0 < 64; c0 += 8) { float kv[8], dc[8];
#pragma unroll
                for (int u = 0; u < 8; ++u) { kv[u] = base[(size_t)(c0 + u) * 2048]; dc[u] = type ? rdec : dec[(c0 + u) * 32]; }
#pragma unroll
                for (int u = 0; u < 8; ++u) { base[(size_t)(c0 + u) * 2048] = s; s = s * dc[u] + kv[u]; } }
        }
    }
    const int bh = bid & 31, rg = bid >> 5, b = bh >> 3, hd = bh & 7, wave = tid >> 6, lane = tid & 63;
    const int m0 = b * SEQ;
    const bf16_t* ZR = (const bf16_t*)(a.ws + OFF_ZR); const bf16_t* PRE = (const bf16_t*)(a.ws + OFF_PRE); bf16_t* YS = (bf16_t*)(a.ws + OFF_YS); const float* G16 = (const float*)(a.ws + OFF_G16);
    constexpr int TB = 32, NBLK = SEQ / TB, REC = 20, STEP = 16 * REC, GOFF = TB * STEP, BUF = GOFF + 128, PBUF = TB * 64, POFF = 2 * BUF;
    static_assert((2 * BUF + 2 * PBUF) * 4 <= 131072, "scan LDS");
    const bool stager = wave >= 4, scanner = wave < 2; const int st = tid - 256, j = st & 15, c = hd * 64 + 4 * j, tok0 = st >> 4;
    struct StRaw { u32x2 r, kx, v, kk, b; f32x4 g; };
    StRaw ra, rb, sa, sb;
#define ST_LOAD(dst, m) do { const bf16_t* zr_ = ZR + (size_t)(m) * 1536 + c; const bf16_t* pr_ = PRE + (size_t)(m) * N2 + c; const float* gp_ = G16 + ((size_t)((m) >> 4) * 8 + hd) * 64 + 4 * j; \
        asm volatile("global_load_dwordx2 %0, %1, off" : "=v"(dst.r) : "v"(zr_) : "memory"); \
        asm volatile("global_load_dwordx2 %0, %1, off offset:1024" : "=v"(dst.kx) : "v"(zr_) : "memory"); \
        asm volatile("global_load_dwordx2 %0, %1, off offset:2048" : "=v"(dst.v) : "v"(zr_) : "memory"); \
        asm volatile("global_load_dwordx2 %0, %1, off offset:1024" : "=v"(dst.kk) : "v"(pr_) : "memory"); \
        asm volatile("global_load_dwordx2 %0, %1, off offset:3072" : "=v"(dst.b) : "v"(pr_) : "memory"); \
        asm volatile("global_load_dwordx4 %0, %1, off" : "=v"(dst.g) : "v"(gp_) : "memory"); } while (0)
#define ST_PIN(dst) asm volatile("" : "+v"(dst.r), "+v"(dst.kx), "+v"(dst.v), "+v"(dst.kk), "+v"(dst.b), "+v"(dst.g))
#define ST_PUT(src, tok, blk) do { lfloat* q_ = lds + ((blk) & 1) * BUF + (tok) * STEP + j * REC; \
        *(LAS f32x4*)(q_) = unpack4(src.kk); *(LAS f32x4*)(q_ + 4) = unpack4(src.b); *(LAS f32x4*)(q_ + 8) = unpack4(src.kx); *(LAS f32x4*)(q_ + 12) = unpack4(src.r); *(LAS f32x4*)(q_ + 16) = unpack4(src.v); \
        if (((tok) & 15) == 0) *(LAS f32x4*)(lds + ((blk) & 1) * BUF + GOFF + ((tok) >> 4) * 64 + 4 * j) = src.g; } while (0)
#define ST_REDUCE(blk) do { const int tt_ = st >> 3, w_ = (st >> 2) & 1, rl_ = st & 3; \
        const LAS unsigned short* p_ = (const LAS unsigned short*)(lds + POFF + ((blk) & 1) * PBUF) + tt_ * 128 + w_ * 64 + rl_ * 16; \
        const pg8::u32x4 a0_ = *(const LAS pg8::u32x4*)p_, a1_ = *(const LAS pg8::u32x4*)(p_ + 8); \
        float s_ = ((bf2f(a0_[0] & 0xffffu) + bf2f(a0_[0] >> 16)) + (bf2f(a0_[1] & 0xffffu) + bf2f(a0_[1] >> 16))) + ((bf2f(a0_[2] & 0xffffu) + bf2f(a0_[2] >> 16)) + (bf2f(a0_[3] & 0xffffu) + bf2f(a0_[3] >> 16))); \
        s_ += ((bf2f(a1_[0] & 0xffffu) + bf2f(a1_[0] >> 16)) + (bf2f(a1_[1] & 0xffffu) + bf2f(a1_[1] >> 16))) + ((bf2f(a1_[2] & 0xffffu) + bf2f(a1_[2] >> 16)) + (bf2f(a1_[3] & 0xffffu) + bf2f(a1_[3] >> 16))); \
        YS[(size_t)(m0 + (blk) * TB + tt_) * 512 + hd * 64 + rg * 8 + w_ * 4 + rl_] = f2bf1(s_); } while (0)
    if (stager) { ST_LOAD(ra, m0 + tok0); ST_LOAD(rb, m0 + tok0 + 16); asm volatile("s_waitcnt vmcnt(0)" ::: "memory"); ST_PIN(ra); ST_PIN(rb); ST_PUT(ra, tok0, 0); ST_PUT(rb, tok0 + 16, 0);
        ST_LOAD(ra, m0 + TB + tok0); ST_LOAD(rb, m0 + TB + tok0 + 16); ST_LOAD(sa, m0 + 2 * TB + tok0); ST_LOAD(sb, m0 + 2 * TB + tok0 + 16); }
    LDS_BARRIER();
    f32x4 S = {0.f, 0.f, 0.f, 0.f};
    const int q = lane & 15, vrow = rg * 8 + (wave & 1) * 4 + (lane >> 4);
#define SCAN_BODY(i, XA, XB) do { \
        if (stager) { \
            if ((i) + 1 < NBLK) { if ((i) + 2 < NBLK) asm volatile("s_waitcnt vmcnt(12)" ::: "memory"); else asm volatile("s_waitcnt vmcnt(0)" ::: "memory"); ST_PIN(XA); ST_PIN(XB); ST_PUT(XA, tok0, (i) + 1); ST_PUT(XB, tok0 + 16, (i) + 1); }     \
            if ((i) > 0) ST_REDUCE((i) - 1); \
            if ((i) + 3 < NBLK) { const int t3_ = m0 + ((i) + 3) * TB + tok0; ST_LOAD(XA, t3_); ST_LOAD(XB, t3_ + 16); } \
        } else if (scanner) { \
            const lfloat* buf = lds + ((i) & 1) * BUF + q * REC; const lfloat* vb = lds + ((i) & 1) * BUF + (vrow >> 2) * REC + 16 + (vrow & 3); const lfloat* gb = lds + ((i) & 1) * BUF + GOFF + 4 * q; \
            LAS unsigned short* pp = (LAS unsigned short*)(lds + POFF + ((i) & 1) * PBUF) + (wave & 1) * 64 + lane; \
            f32x4 XK[4], XB_[4], XX[4], XR[4]; float VV[4]; \
            _Pragma("unroll") for (int t_ = 0; t_ < 3; ++t_) { const lfloat* p = buf + t_ * STEP; XK[t_] = *(const LAS f32x4*)p; XB_[t_] = *(const LAS f32x4*)(p + 4); XX[t_] = *(const LAS f32x4*)(p + 8); XR[t_] = *(const LAS f32x4*)(p + 12); VV[t_] = vb[t_ * STEP]; } \
            _Pragma("unroll") for (int tt = 0; tt < TB; ++tt) { \
                if (tt + 3 < TB) { const lfloat* p = buf + (tt + 3) * STEP; const int s_ = (tt + 3) & 3; XK[s_] = *(const LAS f32x4*)p; XB_[s_] = *(const LAS f32x4*)(p + 4); XX[s_] = *(const LAS f32x4*)(p + 8); XR[s_] = *(const LAS f32x4*)(p + 12); VV[s_] = vb[(tt + 3) * STEP]; } \
                const f32x4 kk = XK[tt & 3], bb = XB_[tt & 3], kx = XX[tt & 3], r = XR[tt & 3]; const float vv = VV[tt & 3]; \
                const float dk = row_allreduce16(sum4(S * kk)); \
                S = S + (vv * kx - dk * bb); \
                pp[tt * 128] = (unsigned short)(__float_as_uint(sum4(S * r)) >> 16);     \
                if ((tt & 15) == 15) S = S * *(const LAS f32x4*)(gb + (tt >> 4) * 64); }     \
        } \
        LDS_BARRIER(); } while (0)
    for (int i = 0; i < NBLK; i += 2) { SCAN_BODY(i, ra, rb); SCAN_BODY(i + 1, sa, sb); }
    if (stager) ST_REDUCE(NBLK - 1);
    asm volatile("s_waitcnt vmcnt(0)" ::: "memory");
#undef SCAN_BODY
#undef ST_REDUCE
#undef ST_LOAD
#undef ST_PIN
#undef ST_PUT
}
#define GAS __attribute__((address_space(1)))
constexpr size_t OFF_BAR = 512 * 1024, BAR_BYTES = 16384;
#define XB_TMO      128
#define XB_XCNT(j)  (256  + 64 * (j))
#define XB_XSUB(j)  (1280 + 64 * (j))
#define XB_XGEN(j)  (2304 + 64 * (j))
#define XB_TOP      3328
#define XB_TOPGEN   3392
#define XCD_BAR_WORDS 3456
#define XB_SPIN_CAP (1u << 18)

__device__ __forceinline__ unsigned xb_ld(unsigned* p)              { return __hip_atomic_load(p, __ATOMIC_RELAXED, __HIP_MEMORY_SCOPE_AGENT); }
__device__ __forceinline__ unsigned xb_add(unsigned* p, unsigned v) { return __hip_atomic_fetch_add(p, v, __ATOMIC_RELAXED, __HIP_MEMORY_SCOPE_AGENT); }
__device__ __forceinline__ unsigned xb_xcc_id() { return (unsigned)__builtin_amdgcn_s_getreg((3 << 11) | 20) & 0xFu; }
#define XB_SPIN(cond, bar) do { unsigned _sp = 0; while (cond) { __builtin_amdgcn_s_sleep(1); \
    if ((++_sp & 255u) == 0u) { if (xb_ld(&(bar)[XB_TMO])) break; if (_sp > XB_SPIN_CAP) { atomicAdd(&(bar)[XB_TMO], 1u); break; } } } } while (0)

struct XcdBarrier {
    unsigned* bar; unsigned x;
    volatile LAS unsigned* st;
};

__device__ __forceinline__ XcdBarrier xcd_barrier_post(unsigned* bar, volatile LAS unsigned* st) {
    XcdBarrier b; b.bar = bar; b.x = xb_xcc_id(); b.st = st;
    if (threadIdx.x == 0) (void)xb_add(&bar[XB_XCNT(b.x)], 1u);
    return b;
}
__device__ __forceinline__ void xcd_barrier_complete(unsigned* bar, unsigned x, unsigned& nloc, unsigned& nx) {
    const unsigned G = gridDim.x * gridDim.y * gridDim.z;
    unsigned sum, cnt, mine, sp = 0u;
    for (;;) {
        sum = 0u; cnt = 0u; mine = 0u;
#pragma unroll
        for (unsigned j = 0; j < 16; ++j) { const unsigned c = xb_ld(&bar[XB_XCNT(j)]); sum += c; cnt += (c > 0u) ? 1u : 0u; mine = (j == x) ? c : mine; }
        if (sum == G) break;
        __builtin_amdgcn_s_sleep(1);
        if ((++sp & 255u) == 0u) { if (xb_ld(&bar[XB_TMO])) break; if (sp > XB_SPIN_CAP) { atomicAdd(&bar[XB_TMO], 1u); break; } }
    }
    nloc = mine > 0u ? mine : 1u; nx = cnt > 0u ? cnt : 1u;
}

__device__ __forceinline__ void xcd_barrier(const XcdBarrier& b) {
    asm volatile("s_waitcnt vmcnt(0)" ::: "memory");
    __syncthreads();
    if (threadIdx.x == 0) {
        unsigned* bar = b.bar;
        __builtin_amdgcn_s_waitcnt(0);
        unsigned nloc = b.st[0], nx = b.st[1];
        if (nloc == 0u) { xcd_barrier_complete(bar, b.x, nloc, nx); b.st[0] = nloc; b.st[1] = nx; }
        const unsigned old = xb_add(&bar[XB_XSUB(b.x)], 1u);
        const unsigned gen = old / nloc;
        if (old + 1u == (gen + 1u) * nloc) {
            __builtin_amdgcn_fence(__ATOMIC_RELEASE, "agent");
            asm volatile("s_waitcnt vmcnt(0)" ::: "memory");
            const unsigned og = xb_add(&bar[XB_TOP], 1u);
            const unsigned tg = og / nx;
            if (og + 1u == (tg + 1u) * nx) xb_add(&bar[XB_TOPGEN], 1u);
            else XB_SPIN(xb_ld(&bar[XB_TOPGEN]) == tg, bar);
            __builtin_amdgcn_fence(__ATOMIC_ACQUIRE, "agent");
            xb_add(&bar[XB_XGEN(b.x)], 1u);
            asm volatile("s_waitcnt vmcnt(0)" ::: "memory");
        } else {
            XB_SPIN(xb_ld(&bar[XB_XGEN(b.x)]) == gen, bar);
            __builtin_amdgcn_fence(__ATOMIC_ACQUIRE, "agent");
            asm volatile("s_waitcnt vmcnt(0)" ::: "memory");
        }
    }
    __syncthreads();
}

__global__ void __launch_bounds__(512, 2) mega_fwd(Args a_unused) {
    CArgs* ap0 = (CArgs*)__builtin_amdgcn_kernarg_segment_ptr();
    extern __shared__ __attribute__((aligned(16))) unsigned char lds_raw[];
    LAS unsigned char* ldsb = (LAS unsigned char*)lds_raw; lfloat* ldsf = (lfloat*)lds_raw;
    cg::grid_group grid = cg::this_grid();
    const int ph_lo = ap0->ph_lo, ph_hi = ap0->ph_hi, coop = ap0->coop;
    volatile LAS unsigned* MISC = (volatile LAS unsigned*)(ldsb + 131072);
    if (threadIdx.x < 16) MISC[threadIdx.x] = 0u;
    __syncthreads();
    const XcdBarrier xbar = xcd_barrier_post((unsigned*)(ap0->ws + OFF_BAR), MISC + 8);
    for (int ph = ph_lo; ph < ph_hi; ++ph) {
        const int l = ph / NPH, k = ph % NPH;
        const int nrep = (ph < NL * NPH && ((DUPMASK >> k) & 1)) ? 2 : 1;
        for (int rep = 0; rep < nrep; ++rep) {
        if (rep) { if (coop == 2) grid.sync(); else if (coop) xcd_barrier(xbar); }
        CArgs* ap = launder_args(ap0); CArgs& a = *ap;
        unsigned char* ws = a.ws; const int G = gridDim.x, bx = lbid();
        float* MOD = (float*)(ws + OFF_MOD);
        bf16_t* XN = (bf16_t*)(ws + OFF_XN); bf16_t* ZR = (bf16_t*)(ws + OFF_ZR); bf16_t* ZG = (bf16_t*)(ws + OFF_ZG); bf16_t* ZX = (bf16_t*)(ws + OFF_ZX);
        bf16_t* PRE = (bf16_t*)(ws + OFF_PRE); bf16_t* HFF = (bf16_t*)(ws + OFF_HFF);
        const float* mod = MOD + l * 4 * 6144;
        if (ph == NL * NPH) { phase_finalnorm(a.out, a.in[34]); }
        else if (k == 0 && (PHMASK & 1)) { if (l == 0) phase_adaln(a, ldsf); phase_weights(ap, l); __syncthreads(); phase_weights_tiled(ap, l, ldsf); }
        else if (k == 1 && (PHMASK >> 1 & 1)) { phase_modnorm(l == 0 ? a.in[0] : a.out, a.in[4] + l * DM, mod, 0, XN); }
        else if (k == 2 && (PHMASK >> 2 & 1)) { pg8::Gemm g{XN, (const bf16_t*)(ws + OFF_WIN), MT, NIN, DM, DM}; pg8::StaticOrder S; S.init(MT, NIN, G, bx); pg8::EpiIn E{ZR, ZG, ZX};
            pg8::gemm_phase<pg8::EpiIn, pg8::StaticOrder, true, true>(ldsb, g, S, E); }
        else if (k == 3 && (PHMASK >> 3 & 1)) { phase_loramid(ZX, XN, ZR, (bf16_t*)(ws + OFF_BND)); }
        else if (k == 4 && (PHMASK >> 4 & 1)) { pg8::Gemm g{XN, (const bf16_t*)(ws + OFF_W2L), MT, N2, K2, K2}; pg8::StaticOrder S; S.init(MT, N2, G, bx); pg8::EpiPlain E{PRE, N2};
            pg8::gemm_phase<pg8::EpiPlain, pg8::StaticOrder, true, true>(ldsb, g, S, E); }
        else if (k == 5 && (PHMASK >> 5 & 1)) { phase_rwkv_prep(a, l); phase_glaret_kv(a, l, ldsf); }
        else if (k == 6 && (PHMASK >> 6 & 1)) { phase_scan(a, l, ldsf, rep == 0); }
        else if (k == 7 && (PHMASK >> 7 & 1)) { phase_rwkv_out(a, l); phase_glaret_out(a, l, ldsf); }
        else if (k == 8 && (PHMASK >> 8 & 1)) { pg8::Gemm g{PRE, (const bf16_t*)(ws + OFF_WO), MT, DM, DM, N2}; pg8::StaticOrder S; S.init(MT, DM, G, bx); pg8::EpiRes E{l == 0 ? a.in[0] : a.out, a.out, mod + 2048};
            pg8::gemm_phase<pg8::EpiRes, pg8::StaticOrder, true, true>(ldsb, g, S, E); }
        else if (k == 9 && (PHMASK >> 9 & 1)) { phase_modnorm(a.out, a.in[5] + l * DM, mod, 3072, XN); }
        else if (k == 10 && (PHMASK >> 10 & 1)) { pg8::Gemm g{XN, (const bf16_t*)(ws + OFF_WGU), MT, NGU, DM, DM}; pg8::StaticOrder S; S.init(MT, NGU, G, bx); pg8::EpiSwiGLU E{HFF};
            pg8::gemm_phase<pg8::EpiSwiGLU, pg8::StaticOrder, true, true>(ldsb, g, S, E); }
        else if (PHMASK >> 11 & 1) { pg8::Gemm g{HFF, (const bf16_t*)(ws + OFF_WD), MT, DM, DFF, DFF}; pg8::StaticOrder S; S.init(MT, DM, G, bx); pg8::EpiRes E{a.out, a.out, mod + 5120};
            pg8::gemm_phase<pg8::EpiRes, pg8::StaticOrder, true, true>(ldsb, g, S, E); }
        }
        if (ph + 1 < ph_hi) { if (coop == 2) grid.sync(); else if (coop) { xcd_barrier(xbar); for (int xs = 0; xs < EXTRA_SYNCS; ++xs) xcd_barrier(xbar); } }
    }
}

constexpr int LDS_BYTES = 147456;
extern "C" void kernel_launch(void* const* d_in, const int* in_sizes, int n_in, void* d_out, int out_size, void* d_ws, size_t ws_size, hipStream_t stream) {
    static int grid = 0;
    if (grid == 0) {
        if (n_in != 35 || out_size != MT * DM || ws_size < OFF_END) { fprintf(stderr, "kernel_launch: unexpected problem (n_in %d out %d ws %zu)\n", n_in, out_size, ws_size); grid = -1; return; }
        int dev = 0, cus = 0, per_cu = 0;
        hipGetDevice(&dev); hipDeviceGetAttribute(&cus, hipDeviceAttributeMultiprocessorCount, dev);
        hipFuncSetAttribute((const void*)mega_fwd, hipFuncAttributeMaxDynamicSharedMemorySize, LDS_BYTES);
        hipOccupancyMaxActiveBlocksPerMultiprocessor(&per_cu, (const void*)mega_fwd, 512, LDS_BYTES);
        if (per_cu < 1) { fprintf(stderr, "kernel_launch: occupancy query says %d blocks per CU\n", per_cu); per_cu = 1; }
        (void)hipGetLastError();
        grid = cus;
    }
    if (grid < 0) return;
    Args a{};
    for (int i = 0; i < 35; ++i) a.in[i] = (const float*)d_in[i];
    a.out = (float*)d_out; a.ws = (unsigned char*)d_ws;
#if MK_MULTI
    for (int ph = 0; ph <= NL * NPH; ++ph) { a.ph_lo = ph; a.ph_hi = ph + 1; a.coop = 0; hipLaunchKernelGGL(mega_fwd, dim3(grid), dim3(512), LDS_BYTES, stream, a); }
#else
    a.ph_lo = 0; a.ph_hi = NL * NPH + 1; a.coop = 1;
    if (hipMemsetAsync((unsigned char*)d_ws + OFF_BAR, 0, BAR_BYTES, stream) != hipSuccess) { fprintf(stderr, "memset failed\n"); return; }
    void* args[] = {&a};
    hipError_t e = hipLaunchCooperativeKernel((const void*)mega_fwd, dim3(grid), dim3(512), args, LDS_BYTES, stream);
    if (e != hipSuccess) fprintf(stderr, "cooperative launch failed: %s (grid %d)\n", hipGetErrorString(e), grid);
#endif
}
```

```cpp
#include <hip/hip_runtime.h>
#include <hip/hip_cooperative_groups.h>
#include <cstdio>
#include <cstdint>
namespace cg = cooperative_groups;
#ifndef MK_MULTI
#define MK_MULTI 0
#endif
__device__ __forceinline__ int ltid() { int t = threadIdx.x; asm volatile("" : "+v"(t)); return t; }
__device__ __forceinline__ int lbid() { int b = blockIdx.x; asm volatile("" : "+s"(b)); return b; }
namespace pg8 {
#define PG8_LAS __attribute__((address_space(3)))
typedef unsigned short bf16_t;
typedef short bf16x8 __attribute__((ext_vector_type(8)));
typedef float f32x4 __attribute__((ext_vector_type(4)));
typedef unsigned u32x4 __attribute__((ext_vector_type(4)));
constexpr int BM = 256, BK = 64, HALF = 128, HTB = HALF * BK * 2  , STAGE_BYTES = 8 * HTB, NXCD = 8, WGM = 8;

__host__ __device__ __forceinline__ int lds_byte(int r, int c) { const int st = (r >> 4) * 2 + (c >> 5), rr = r & 15, cc = c & 31, ob = rr * 64 + cc * 2; return st * 1024 + (ob ^ (((ob >> 9) & 1) << 5)); }
__host__ __device__ __forceinline__ void stage_rc(int b, int& R, int& C) { const int st = b / 1024, sb = b % 1024, swz = sb ^ (((sb >> 9) & 1) << 5); R = (st >> 1) * 16 + swz / 64; C = (st & 1) * 32 + (swz % 64) / 2; }
__host__ __device__ __forceinline__ int perm32(int rho) { const int n = rho >> 4, i = rho & 15; return 8 * (i >> 2) + 4 * n + (i & 3); }

struct Unit { int pm, pn; };
struct Gemm { const bf16_t* A; const bf16_t* Bt; int M, N, K, lda; };

struct StaticOrder {
    int nM, nN, nwg, G, c;
    __host__ __device__ void init(int M, int N, int G_, int c_) { nM = M / BM; nN = N / BM; nwg = nM * nN; G = G_; c = c_; }
    __host__ __device__ bool next(int i, Unit& u) const {
        const long L = (long)i * G + c; if (L >= nwg) return false;
        int wgid = (int)L; { const int q = nwg / NXCD, r = nwg % NXCD, xcd = wgid % NXCD, off = wgid / NXCD; wgid = (xcd < r ? xcd * (q + 1) : r * (q + 1) + (xcd - r) * q) + off; }
        const int nig = WGM * nN, gid = wgid / nig, fm = gid * WGM, gsz = (nM - fm) < WGM ? (nM - fm) : WGM;
        u.pm = fm + ((wgid % nig) % gsz); u.pn = (wgid % nig) / gsz; return true;
    }
    __device__ __forceinline__ void a_ready(const Unit&) const {}
    __device__ __forceinline__ void done(const Unit&) const {}
};

__device__ __forceinline__ unsigned cvt_pk_bf16(float lo, float hi) { unsigned r; asm volatile("v_cvt_pk_bf16_f32 %0, %1, %2" : "=v"(r) : "v"(lo), "v"(hi)); return r; }
typedef float f32x2 __attribute__((ext_vector_type(2)));
__device__ __forceinline__ f32x2 gelu_pk(f32x2 v) {
    const f32x2 av = __builtin_elementwise_abs(v), d = av * 0.2316418882f + 1.0f;
    f32x2 t; t.x = __builtin_amdgcn_rcpf(d.x); t.y = __builtin_amdgcn_rcpf(d.y);
    f32x2 q = t * 0.5307027145f + (-0.7265760135f); q = q * t + 0.7107068705f; q = q * t + (-0.142248368f); q = q * t + 0.127414796f; q = q * t;
    const f32x2 s = (v * v) * (-0.72134752044f);
    f32x2 e; e.x = __builtin_amdgcn_exp2f(s.x); e.y = __builtin_amdgcn_exp2f(s.y);
    const f32x2 m = v * (q * e), r = v - m;
    f32x2 o; o.x = v.x < 0.f ? m.x : r.x; o.y = v.y < 0.f ? m.y : r.y; return o;
}

template <int ACT  > struct EpiBf16 {
    static constexpr bool PERM = true, AFTER_DRAIN = false; static_assert(ACT == 0 || ACT == 1, "EpiBf16: ACT is 0 (none) or 1 (gelu_pk)");
    bf16_t* O; int ldc; const float* bias; int split_cols; size_t split_stride; float scale0;
    __device__ __forceinline__ void operator()(const f32x4 (&acc)[2][2][4][2], const Unit& u, int wr, int wc, int fr, int fq) const {
        const int row0 = u.pm * BM + wr * 64 + fr; int colt = u.pn * BM; bf16_t* base = O;
        float sc = 1.f; if (split_cols) { const int t = colt / split_cols; base += (size_t)t * split_stride; colt -= t * split_cols; if (t == 0) sc = scale0; }
        const int col0 = colt + wc * 32 + 8 * fq, bcol0 = u.pn * BM + wc * 32 + 8 * fq;
        f32x4 bv[2][2];
#pragma unroll
        for (int bj = 0; bj < 2; ++bj)
#pragma unroll
            for (int n = 0; n < 2; ++n) bv[bj][n] = bias ? *(const f32x4*)(bias + bcol0 + bj * HALF + 4 * n) : (f32x4){0.f, 0.f, 0.f, 0.f};
#pragma unroll
        for (int ai = 0; ai < 2; ++ai)
#pragma unroll
            for (int m = 0; m < 4; ++m) { bf16_t* rowp = base + (size_t)(row0 + ai * HALF + m * 16) * ldc + col0;
#pragma unroll
                for (int bj = 0; bj < 2; ++bj) { f32x4 v0 = acc[ai][bj][m][0] + bv[bj][0], v1 = acc[ai][bj][m][1] + bv[bj][1];
                    if (ACT == 1) { f32x2 a = gelu_pk((f32x2){v0[0], v0[1]}), b = gelu_pk((f32x2){v0[2], v0[3]}), c = gelu_pk((f32x2){v1[0], v1[1]}), d = gelu_pk((f32x2){v1[2], v1[3]});
                        v0 = (f32x4){a.x, a.y, b.x, b.y}; v1 = (f32x4){c.x, c.y, d.x, d.y}; }
                    v0 = v0 * sc; v1 = v1 * sc; u32x4 w; w.x = cvt_pk_bf16(v0[0], v0[1]); w.y = cvt_pk_bf16(v0[2], v0[3]); w.z = cvt_pk_bf16(v1[0], v1[1]); w.w = cvt_pk_bf16(v1[2], v1[3]);
                    *(u32x4*)(rowp + bj * HALF) = w; } }
    }
};
template <class Epi, class Sched, bool ALIGN_EPI = false, bool SP2 = false>
__device__ __forceinline__ void gemm_phase(PG8_LAS unsigned char* lds, const Gemm g, const Sched& S, const Epi& E) {
    const int tid = ltid(), wid = __builtin_amdgcn_readfirstlane(tid >> 6), lane = tid & 63, wr = wid >> 2, wc = wid & 3, fr = lane & 15, fq = lane >> 4;
    const int K = g.K, nt = K / BK;
    unsigned voffA[2], voffB[2];
#pragma unroll
    for (int i = 0; i < 2; ++i) { int R, C; stage_rc(tid * 16 + i * 8192, R, C); const int Rb = Epi::PERM ? ((R & ~31) + perm32(R & 31)) : R;
        voffA[i] = (unsigned)(R * g.lda + C) * 2u; voffB[i] = (unsigned)(Rb * K + C) * 2u; }
    const size_t kstep = (size_t)(BK * 2);
    const size_t hstep = (size_t)HALF * K * 2;
    const size_t tstep = 2 * hstep; const size_t hstepA = (size_t)HALF * g.lda * 2, tstepA = 2 * hstepA;
    const unsigned ldsw = (unsigned)wid * 1024u;
    const int aoff = lds_byte(wr * 64 + fr, fq * 8), boff = lds_byte(wc * 32 + fr, fq * 8);
#define PG8_SA(b, h) (((b) * 2 + (h)) * HTB)
#define PG8_SB(b, h) ((4 + (b) * 2 + (h)) * HTB)
#define PG8_STAGE(bufoff, gbase, voff) do { _Pragma("unroll") for (int _i = 0; _i < 2; ++_i) \
        __builtin_amdgcn_global_load_lds((const unsigned*)((const char*)(gbase) + (voff)[_i]), (PG8_LAS unsigned*)(lds + (bufoff) + ldsw + _i * 8192), 16, 0, 0); } while (0)
#define PG8_LDA(dst, b, h) do { _Pragma("unroll") for (int m = 0; m < 4; ++m) _Pragma("unroll") for (int k = 0; k < 2; ++k) dst[m][k] = *(const PG8_LAS bf16x8*)(lds + PG8_SA(b, h) + aoff + m * 2048 + k * 1024); } while (0)
#define PG8_LDB(dst, b, h) do { _Pragma("unroll") for (int n = 0; n < 2; ++n) _Pragma("unroll") for (int k = 0; k < 2; ++k) dst[n][k] = *(const PG8_LAS bf16x8*)(lds + PG8_SB(b, h) + boff + n * 2048 + k * 1024); } while (0)
#define PG8_MMA(ai, bj, At, Bt) do { __builtin_amdgcn_s_setprio(1); _Pragma("unroll") for (int m = 0; m < 4; ++m) _Pragma("unroll") for (int n = 0; n < 2; ++n) _Pragma("unroll") for (int k = 0; k < 2; ++k) \
        acc[ai][bj][m][n] = __builtin_amdgcn_mfma_f32_16x16x32_bf16(Bt[n][k], At[m][k], acc[ai][bj][m][n], 0, 0, 0); __builtin_amdgcn_s_setprio(0); } while (0)
#define PG8_WAIT_V(n) asm volatile("s_waitcnt vmcnt(" #n ")" ::: "memory")
#define PG8_WAIT_L(n) asm volatile("s_waitcnt lgkmcnt(" #n ")" ::: "memory")
#define PG8_BAR __builtin_amdgcn_s_barrier()
#define PG8_SCHED __builtin_amdgcn_sched_barrier(0)
    Unit cur, nxt; int ui = 0;
    if (!S.next(0, cur)) return;
    f32x4 acc[2][2][4][2];
#pragma unroll
    for (int a = 0; a < 2; ++a)
#pragma unroll
        for (int b = 0; b < 2; ++b)
#pragma unroll
            for (int m = 0; m < 4; ++m)
#pragma unroll
                for (int n = 0; n < 2; ++n) acc[a][b][m][n] = (f32x4){0.f, 0.f, 0.f, 0.f};
    bf16x8 At[4][2], B0[2][2], B1[2][2];
    const char* cA = (const char*)g.A + (size_t)cur.pm * tstepA; const char* cB = (const char*)g.Bt + (size_t)cur.pn * tstep;
    S.a_ready(cur);
    if constexpr (SP2) {
        PG8_STAGE(PG8_SB(0, 0), cB, voffB); PG8_STAGE(PG8_SB(0, 1), cB + hstep, voffB); PG8_STAGE(PG8_SA(0, 0), cA, voffA); PG8_STAGE(PG8_SA(0, 1), cA + hstepA, voffA);
        if (wr == 1) PG8_BAR;
        PG8_WAIT_V(2); PG8_BAR;
        PG8_STAGE(PG8_SB(1, 0), cB + kstep, voffB); PG8_STAGE(PG8_SA(1, 0), cA + kstep, voffA); PG8_STAGE(PG8_SB(1, 1), cB + hstep + kstep, voffB);
        PG8_WAIT_V(6); PG8_BAR;
    } else {
        PG8_STAGE(PG8_SB(0, 0), cB, voffB); PG8_STAGE(PG8_SA(0, 0), cA, voffA); PG8_STAGE(PG8_SB(0, 1), cB + hstep, voffB); PG8_STAGE(PG8_SA(0, 1), cA + hstepA, voffA);
        if (wr == 1) PG8_BAR;
        PG8_WAIT_V(4); PG8_BAR;
        PG8_STAGE(PG8_SB(1, 0), cB + kstep, voffB); PG8_STAGE(PG8_SA(1, 0), cA + kstep, voffA); PG8_STAGE(PG8_SB(1, 1), cB + hstep + kstep, voffB);
        PG8_WAIT_V(6); PG8_BAR;
    }
    for (;;) {
        const bool has_next = S.next(ui + 1, nxt);
        const char* nA = has_next ? (const char*)g.A + (size_t)nxt.pm * tstepA : cA; const char* nB = has_next ? (const char*)g.Bt + (size_t)nxt.pn * tstep : cB;
        _Pragma("unroll 1") for (int t = 0; t < nt; t += 2) {
            const bool last = (t == nt - 2);
            const char* a1 = cA + (size_t)(t + 1) * kstep;
            const char* a2 = last ? nA : cA + (size_t)(t + 2) * kstep; const char* b2 = last ? nB : cB + (size_t)(t + 2) * kstep;
            const char* a3 = a2 + kstep; const char* b3 = b2 + kstep;
            if (last && has_next) S.a_ready(nxt);
            if constexpr (SP2) {
            PG8_LDB(B0, 0, 0); PG8_LDB(B1, 0, 1); PG8_SCHED; PG8_LDA(At, 0, 0); PG8_STAGE(PG8_SA(1, 1), a1 + hstepA, voffA);
            PG8_WAIT_V(8); PG8_WAIT_L(0); PG8_BAR; PG8_MMA(0, 0, At, B0); PG8_MMA(0, 1, At, B1); PG8_BAR; PG8_SCHED;
            PG8_LDA(At, 0, 1); PG8_STAGE(PG8_SB(0, 0), b2, voffB); PG8_STAGE(PG8_SB(0, 1), b2 + hstep, voffB); PG8_STAGE(PG8_SA(0, 0), a2, voffA);
            PG8_WAIT_V(8); PG8_WAIT_L(0); PG8_BAR; PG8_MMA(1, 0, At, B0); PG8_MMA(1, 1, At, B1); PG8_BAR; PG8_SCHED;
            PG8_LDB(B0, 1, 0); PG8_LDB(B1, 1, 1); PG8_SCHED; PG8_LDA(At, 1, 0); PG8_STAGE(PG8_SA(0, 1), a2 + hstepA, voffA);
            PG8_WAIT_V(8); PG8_WAIT_L(0); PG8_BAR; PG8_MMA(0, 0, At, B0); PG8_MMA(0, 1, At, B1); PG8_BAR; PG8_SCHED;
            PG8_LDA(At, 1, 1); PG8_STAGE(PG8_SB(1, 0), b3, voffB); PG8_STAGE(PG8_SB(1, 1), b3 + hstep, voffB); PG8_STAGE(PG8_SA(1, 0), a3, voffA);
            PG8_WAIT_V(8); PG8_WAIT_L(0); PG8_BAR; PG8_MMA(1, 0, At, B0); PG8_MMA(1, 1, At, B1); PG8_BAR; PG8_SCHED;
            } else {
            PG8_LDB(B0, 0, 0); PG8_SCHED; PG8_LDA(At, 0, 0); PG8_STAGE(PG8_SA(1, 1), a1 + hstepA, voffA);
            PG8_WAIT_L(8); PG8_BAR; PG8_WAIT_L(0); PG8_MMA(0, 0, At, B0); PG8_BAR; PG8_SCHED;
            PG8_LDB(B1, 0, 1); PG8_STAGE(PG8_SB(0, 0), b2, voffB);
            PG8_BAR; PG8_WAIT_L(0); PG8_MMA(0, 1, At, B1); PG8_BAR;
            PG8_LDA(At, 0, 1); PG8_STAGE(PG8_SA(0, 0), a2, voffA);
            PG8_BAR; PG8_WAIT_L(0); PG8_MMA(1, 0, At, B0); PG8_BAR; PG8_SCHED;
            PG8_STAGE(PG8_SB(0, 1), b2 + hstep, voffB);
            PG8_WAIT_V(6); PG8_BAR; PG8_MMA(1, 1, At, B1); PG8_BAR;
            PG8_LDB(B0, 1, 0); PG8_SCHED; PG8_LDA(At, 1, 0); PG8_STAGE(PG8_SA(0, 1), a2 + hstepA, voffA);
            PG8_WAIT_L(8); PG8_BAR; PG8_WAIT_L(0); PG8_MMA(0, 0, At, B0); PG8_BAR; PG8_SCHED;
            PG8_LDB(B1, 1, 1); PG8_STAGE(PG8_SB(1, 0), b3, voffB);
            PG8_BAR; PG8_WAIT_L(0); PG8_MMA(0, 1, At, B1); PG8_BAR;
            PG8_LDA(At, 1, 1); PG8_STAGE(PG8_SA(1, 0), a3, voffA);
            PG8_BAR; PG8_WAIT_L(0); PG8_MMA(1, 0, At, B0); PG8_BAR; PG8_SCHED;
            PG8_STAGE(PG8_SB(1, 1), b3 + hstep, voffB);
            PG8_WAIT_V(6); PG8_BAR; PG8_MMA(1, 1, At, B1); PG8_BAR;
            }
        }
        if constexpr (ALIGN_EPI) { if (wr == 0) PG8_BAR; }
        if constexpr (!Epi::AFTER_DRAIN) { E(acc, cur, wr, wc, fr, fq); S.done(cur); }
        if (!has_next) break;
#pragma unroll
        for (int a = 0; a < 2; ++a)
#pragma unroll
            for (int b = 0; b < 2; ++b)
#pragma unroll
                for (int m = 0; m < 4; ++m)
#pragma unroll
                    for (int n = 0; n < 2; ++n) acc[a][b][m][n] = (f32x4){0.f, 0.f, 0.f, 0.f};
        cur = nxt; cA = nA; cB = nB; ++ui;
        if constexpr (ALIGN_EPI) { if (wr == 1) PG8_BAR; }
    }
    PG8_WAIT_V(0);
    if constexpr (!ALIGN_EPI) { if (wr == 0) PG8_BAR; }
    PG8_BAR;
    if constexpr (Epi::AFTER_DRAIN) { E.fused(acc, cur, wr, wc, fr, fq, lds, wid, lane); S.done(cur); }
#undef PG8_SA
#undef PG8_SB
#undef PG8_STAGE
#undef PG8_LDA
#undef PG8_LDB
#undef PG8_MMA
#undef PG8_WAIT_V
#undef PG8_WAIT_L
#undef PG8_BAR
#undef PG8_SCHED
}
}

#define LAS __attribute__((address_space(3)))
typedef unsigned short bf16_t;
typedef float f32x4 __attribute__((ext_vector_type(4)));
typedef LAS float lfloat;

constexpr int NB = 4, SEQ = 4096, DM = 1024, MT = NB * SEQ, NL = 2;
constexpr int NIN = 3840, K2 = 384, N2 = 2304, DFF = 2816, NGU = 5632;
#ifndef EXTRA_SYNCS
#define EXTRA_SYNCS 0
#endif
#ifndef SCAN_TWICE
#define SCAN_TWICE 0
#endif
#ifndef XTRA_LDS
#define XTRA_LDS 0
#endif
#ifndef DUPMASK
#define DUPMASK 0
#endif
#ifndef PHMASK
#define PHMASK 0xfff
#endif
constexpr int NPH = 12;
constexpr size_t MiB = 1u << 20;
constexpr size_t OFF_MOD = 0, OFF_DEC = 1 * MiB, OFF_W = 2 * MiB;
constexpr size_t OFF_WIN = OFF_W, OFF_WO = OFF_WIN + (size_t)NIN * DM * 2, OFF_WGU = OFF_WO + (size_t)DM * DM * 2,
                 OFF_WD = OFF_WGU + (size_t)NGU * DM * 2, OFF_W2L = OFF_WD + (size_t)DM * DFF * 2, OFF_WEND = OFF_W2L + (size_t)N2 * K2 * 2;
constexpr size_t OFF_VF = 30 * MiB, OFF_XN = 46 * MiB, OFF_KV = OFF_XN, OFF_YS = OFF_XN + 16 * MiB;
constexpr size_t OFF_ZR = 78 * MiB, OFF_ZG = 126 * MiB, OFF_HFF = OFF_ZR, OFF_PRE = 174 * MiB, OFF_ZX = OFF_PRE, OFF_BND = 246 * MiB, OFF_BON = 250 * MiB, OFF_G16 = 251 * MiB, OFF_END = 253 * MiB;
static_assert(OFF_WEND <= OFF_VF, "weights fit");

struct Args { const float* in[35]; float* out; unsigned char* ws; int ph_lo, ph_hi, coop, pad; };
typedef const __attribute__((address_space(4))) Args CArgs;
__device__ __forceinline__ CArgs* launder_args(CArgs* p) { asm volatile("" : "+s"(p)); return p; }

__device__ __forceinline__ float bf2f(unsigned u16) { return __uint_as_float(u16 << 16); }
__device__ __forceinline__ f32x4 unpack4(uint2 u) { return (f32x4){__uint_as_float(u.x << 16), __uint_as_float(u.x & 0xffff0000u), __uint_as_float(u.y << 16), __uint_as_float(u.y & 0xffff0000u)}; }
typedef unsigned u32x2 __attribute__((ext_vector_type(2)));
__device__ __forceinline__ f32x4 unpack4(u32x2 u) { return (f32x4){__uint_as_float(u[0] << 16), __uint_as_float(u[0] & 0xffff0000u), __uint_as_float(u[1] << 16), __uint_as_float(u[1] & 0xffff0000u)}; }
__device__ __forceinline__ uint2 pack4(f32x4 v) { uint2 r; r.x = pg8::cvt_pk_bf16(v[0], v[1]); r.y = pg8::cvt_pk_bf16(v[2], v[3]); return r; }
__device__ __forceinline__ unsigned short f2bf1(float v) { return (unsigned short)(pg8::cvt_pk_bf16(v, 0.f) & 0xffffu); }
__device__ __forceinline__ float sigmoidf_(float x) { return __builtin_amdgcn_rcpf(1.f + __expf(-x)); }
__device__ __forceinline__ float siluf_(float x) { return x * sigmoidf_(x); }
__device__ __forceinline__ float tanhf_(float x) { return 1.f - 2.f * __builtin_amdgcn_rcpf(__expf(2.f * x) + 1.f); }
__device__ __forceinline__ float softplusf_(float z) { return fmaxf(z, 0.f) + __logf(1.f + __expf(-fabsf(z))); }
__device__ __forceinline__ float row_allreduce16(float v) {
    v += __int_as_float(__builtin_amdgcn_update_dpp(0, __float_as_int(v), 0x128, 0xf, 0xf, false));
    v += __int_as_float(__builtin_amdgcn_update_dpp(0, __float_as_int(v), 0x124, 0xf, 0xf, false));
    v += __int_as_float(__builtin_amdgcn_update_dpp(0, __float_as_int(v), 0x122, 0xf, 0xf, false));
    v += __int_as_float(__builtin_amdgcn_update_dpp(0, __float_as_int(v), 0x121, 0xf, 0xf, false));
    return v;
}
__device__ __forceinline__ float row_allreduce32(float v) {
    v = row_allreduce16(v);
    const auto rr = __builtin_amdgcn_permlane32_swap(__float_as_uint(v), __float_as_uint(v), false, false);
    return __uint_as_float(rr[0]) + __uint_as_float(rr[1]);
}
__device__ __forceinline__ float wave_sum(float v) {
#pragma unroll
    for (int o = 1; o < 64; o <<= 1) v += __shfl_xor(v, o);
    return v;
}
#define LDS_BARRIER() do { asm volatile("s_waitcnt lgkmcnt(0)" ::: "memory"); __builtin_amdgcn_s_barrier(); asm volatile("" ::: "memory"); } while (0)
__device__ __forceinline__ float sum4(f32x4 v) { return (v[0] + v[1]) + (v[2] + v[3]); }

namespace pg8 {
struct EpiIn {
    static constexpr bool PERM = true, AFTER_DRAIN = false;
    bf16_t *ZR, *ZG, *ZX;
    __device__ __forceinline__ void operator()(const f32x4 (&acc)[2][2][4][2], const Unit& u, int wr, int wc, int fr, int fq) const {
        int colt = u.pn * BM; bf16_t* base; int ldc;
        if (colt < 1536) { base = ZR; ldc = 1536; } else if (colt < 3072) { base = ZG; ldc = 1536; colt -= 1536; } else { base = ZX; ldc = 768; colt -= 3072; }
        const int row0 = u.pm * BM + wr * 64 + fr, col0 = colt + wc * 32 + 8 * fq;
#pragma unroll
        for (int ai = 0; ai < 2; ++ai)
#pragma unroll
            for (int m = 0; m < 4; ++m) { bf16_t* rowp = base + (size_t)(row0 + ai * HALF + m * 16) * ldc + col0;
#pragma unroll
                for (int bj = 0; bj < 2; ++bj) { const f32x4 v0 = acc[ai][bj][m][0], v1 = acc[ai][bj][m][1];
                    u32x4 w; w.x = cvt_pk_bf16(v0[0], v0[1]); w.y = cvt_pk_bf16(v0[2], v0[3]); w.z = cvt_pk_bf16(v1[0], v1[1]); w.w = cvt_pk_bf16(v1[2], v1[3]);
                    *(u32x4*)(rowp + bj * HALF) = w; } }
    }
};
struct EpiPlain {
    static constexpr bool PERM = true, AFTER_DRAIN = false;
    bf16_t* O; int ldc;
    __device__ __forceinline__ void operator()(const f32x4 (&acc)[2][2][4][2], const Unit& u, int wr, int wc, int fr, int fq) const {
        const int row0 = u.pm * BM + wr * 64 + fr, col0 = u.pn * BM + wc * 32 + 8 * fq;
#pragma unroll
        for (int ai = 0; ai < 2; ++ai)
#pragma unroll
            for (int m = 0; m < 4; ++m) { bf16_t* rowp = O + (size_t)(row0 + ai * HALF + m * 16) * ldc + col0;
#pragma unroll
                for (int bj = 0; bj < 2; ++bj) { const f32x4 v0 = acc[ai][bj][m][0], v1 = acc[ai][bj][m][1];
                    u32x4 w; w.x = cvt_pk_bf16(v0[0], v0[1]); w.y = cvt_pk_bf16(v0[2], v0[3]); w.z = cvt_pk_bf16(v1[0], v1[1]); w.w = cvt_pk_bf16(v1[2], v1[3]);
                    *(u32x4*)(rowp + bj * HALF) = w; } }
    }
};
struct EpiRes {
    static constexpr bool PERM = true, AFTER_DRAIN = false;
    const float* xin; float* xout; const float* gate;
    __device__ __forceinline__ void operator()(const f32x4 (&acc)[2][2][4][2], const Unit& u, int wr, int wc, int fr, int fq) const {
        const int b = u.pm >> 4; const float* gp = gate + b * 6144;
        const int row0 = u.pm * BM + wr * 64 + fr, col0 = u.pn * BM + wc * 32 + 8 * fq;
        f32x4 gv[2][2];
#pragma unroll
        for (int bj = 0; bj < 2; ++bj)
#pragma unroll
            for (int n = 0; n < 2; ++n) gv[bj][n] = *(const f32x4*)(gp + col0 + bj * HALF + 4 * n);
#pragma unroll
        for (int ai = 0; ai < 2; ++ai)
#pragma unroll
            for (int m = 0; m < 4; ++m) { const size_t off = (size_t)(row0 + ai * HALF + m * 16) * 1024 + col0;
#pragma unroll
                for (int bj = 0; bj < 2; ++bj)
#pragma unroll
                    for (int n = 0; n < 2; ++n) { const f32x4 xi = *(const f32x4*)(xin + off + bj * HALF + 4 * n);
                        *(f32x4*)(xout + off + bj * HALF + 4 * n) = xi + gv[bj][n] * acc[ai][bj][m][n]; } }
    }
};
struct EpiSwiGLU {
    static constexpr bool PERM = true, AFTER_DRAIN = false;
    bf16_t* H;
    __device__ __forceinline__ void operator()(const f32x4 (&acc)[2][2][4][2], const Unit& u, int wr, int wc, int fr, int fq) const {
        const int row0 = u.pm * BM + wr * 64 + fr, col0 = u.pn * HALF + wc * 32 + 8 * fq;
#pragma unroll
        for (int ai = 0; ai < 2; ++ai)
#pragma unroll
            for (int m = 0; m < 4; ++m) { bf16_t* rowp = H + (size_t)(row0 + ai * HALF + m * 16) * DFF + col0;
                f32x4 g0 = acc[ai][0][m][0], g1 = acc[ai][0][m][1]; const f32x4 u0 = acc[ai][1][m][0], u1 = acc[ai][1][m][1];
#pragma unroll
                for (int i = 0; i < 4; ++i) { g0[i] = siluf_(g0[i]) * u0[i]; g1[i] = siluf_(g1[i]) * u1[i]; }
                u32x4 w; w.x = cvt_pk_bf16(g0[0], g0[1]); w.y = cvt_pk_bf16(g0[2], g0[3]); w.z = cvt_pk_bf16(g1[0], g1[1]); w.w = cvt_pk_bf16(g1[2], g1[3]);
                *(u32x4*)rowp = w; }
    }
};
}

template <class F> __device__ __forceinline__ void prep_mat(bf16_t* dst, int NR, int K, int gtid, int gthreads, F src) {
    const int total = NR * (K >> 3);
    for (int i = gtid; i < total; i += gthreads) { const int n = i % NR, kb = i / NR; float v[8];
#pragma unroll
        for (int j = 0; j < 8; ++j) v[j] = src(n, kb * 8 + j);
        uint4 o; o.x = pg8::cvt_pk_bf16(v[0], v[1]); o.y = pg8::cvt_pk_bf16(v[2], v[3]); o.z = pg8::cvt_pk_bf16(v[4], v[5]); o.w = pg8::cvt_pk_bf16(v[6], v[7]);
        *(uint4*)(dst + (size_t)n * K + kb * 8) = o; }
}
template <class F, class R> __device__ __forceinline__ void prep_mat_rm(bf16_t* dst, int NR, int K, int gtid, int gthreads, F src, R rowmap) {
    const int total = NR * (K >> 3);
    for (int i = gtid; i < total; i += gthreads) { const int n = i % NR, kb = i / NR; float v[8];
#pragma unroll
        for (int j = 0; j < 8; ++j) v[j] = src(n, kb * 8 + j);
        uint4 o; o.x = pg8::cvt_pk_bf16(v[0], v[1]); o.y = pg8::cvt_pk_bf16(v[2], v[3]); o.z = pg8::cvt_pk_bf16(v[4], v[5]); o.w = pg8::cvt_pk_bf16(v[6], v[7]);
        *(uint4*)(dst + (size_t)rowmap(n) * K + kb * 8) = o; }
}
__device__ __forceinline__ void transpose_item(const float* W  , int ldw, bf16_t* WT  , int K, lfloat* scr, int lane) {
#pragma unroll 8
    for (int i = 0; i < 32; ++i) { const int kk = 2 * i + (lane >> 5); scr[kk * 33 + (lane & 31)] = W[(size_t)kk * ldw + (lane & 31)]; }
    asm volatile("s_waitcnt lgkmcnt(0)" ::: "memory");
    const int c = lane & 7;
#pragma unroll
    for (int jj = 0; jj < 4; ++jj) { const int n = (lane >> 3) + 8 * jj; const lfloat* p = scr + (8 * c) * 33 + n;
        uint4 o; o.x = pg8::cvt_pk_bf16(p[0], p[33]); o.y = pg8::cvt_pk_bf16(p[66], p[99]); o.z = pg8::cvt_pk_bf16(p[132], p[165]); o.w = pg8::cvt_pk_bf16(p[198], p[231]);
        *(uint4*)(WT + (size_t)n * K + 8 * c) = o; }
    asm volatile("s_waitcnt lgkmcnt(0)" ::: "memory");
}
__device__ __forceinline__ void phase_weights_tiled(CArgs* ap, int l, lfloat* lds) {
    const int tid = ltid(), lane = tid & 63, wave = tid >> 6; lfloat* scr = lds + wave * 2176;
    const int gw = lbid() * 8 + wave, ngw = gridDim.x * 8; unsigned char* ws = ap->ws;
    constexpr int I_IN = 16 * 96, I_O = 16 * 32, I_G = 16 * 88, I_D = 44 * 32, NIT = I_IN + I_O + 2 * I_G + I_D;
    for (int it = gw; it < NIT; it += ngw) { CArgs& a = *launder_args(ap); int r = it;
        if (r < I_IN) { const int kb = r / 96, nb = r % 96; transpose_item(a.in[6] + (size_t)l * DM * 3072 + (size_t)(kb * 64) * 3072 + nb * 32, 3072, (bf16_t*)(ws + OFF_WIN) + (size_t)(nb * 32) * DM + kb * 64, DM, scr, lane); continue; } r -= I_IN;
        if (r < I_O) { const int kb = r / 32, nb = r % 32; const int ks = (kb * 64 + 512) & 1023;
            transpose_item(a.in[7] + (size_t)l * DM * DM + (size_t)ks * DM + nb * 32, DM, (bf16_t*)(ws + OFF_WO) + (size_t)(nb * 32) * DM + kb * 64, DM, scr, lane); continue; } r -= I_O;
        if (r < 2 * I_G) { const int up = r >= I_G; if (up) r -= I_G; const int kb = r / 88, nb = r % 88, n0 = nb * 32; const int row0 = (n0 >> 7) * 256 + (n0 & 127) + (up ? 128 : 0);
            const float* W = (up ? a.in[32] : a.in[31]) + (size_t)l * DM * DFF;
            transpose_item(W + (size_t)(kb * 64) * DFF + n0, DFF, (bf16_t*)(ws + OFF_WGU) + (size_t)row0 * DM + kb * 64, DM, scr, lane); continue; } r -= 2 * I_G;
        { const int kb = r / 32, nb = r % 32; transpose_item(a.in[33] + (size_t)l * DFF * DM + (size_t)(kb * 64) * DM + nb * 32, DM, (bf16_t*)(ws + OFF_WD) + (size_t)(nb * 32) * DFF + kb * 64, DFF, scr, lane); }
    }
}
__device__ __forceinline__ void phase_weights(CArgs* ap, int l) {
    const int gtid = lbid() * 512 + ltid(), gth = gridDim.x * 512;
    unsigned char* ws = ap->ws;
    {   CArgs& a = *launder_args(ap);
        const float* mux = a.in[9] + (size_t)l * 3 * DM; const float* w1 = a.in[11] + (size_t)l * DM * 64; const float* a1 = a.in[14] + (size_t)l * DM * 64;
        const float* g1 = a.in[16] + (size_t)l * DM * 128; const float* muv = a.in[23]; const float* v1 = a.in[25]; const float* ga1 = a.in[27] + (size_t)l * DM * 16;
        prep_mat((bf16_t*)(ws + OFF_WIN) + (size_t)3072 * DM, 768, DM, gtid, gth, [=](int n, int k) -> float {
            if (n < 128) { const float mu = mux[k]; const int j = n & 63; return (n < 64 ? 1.f - mu : mu) * w1[k * 64 + j]; }
            if (n < 256) { const float mu = mux[DM + k]; const int j = n & 63; return (n < 192 ? 1.f - mu : mu) * a1[k * 64 + j]; }
            if (n < 512) { const float mu = mux[2 * DM + k]; const int j = n & 127; return (n < 384 ? 1.f - mu : mu) * g1[k * 128 + j]; }
            if (n < 576) { if (l == 0) return 0.f; const float mu = muv[k]; const int j = n & 31; return (n < 544 ? 1.f - mu : mu) * v1[k * 32 + j]; }
            if (n < 592) return ga1[k * 16 + (n - 576)];
            return 0.f; });
    }
    {   CArgs& a = *launder_args(ap);
        const float* w2 = a.in[12] + (size_t)l * 64 * 512; const float* a2 = a.in[15] + (size_t)l * 64 * 512; const float* g2 = a.in[17] + (size_t)l * 128 * 512;
        const float* v2 = a.in[26]; const float* ga2 = a.in[28] + (size_t)l * 16 * 128;
        prep_mat((bf16_t*)(ws + OFF_W2L), N2, K2, gtid, gth, [=](int n, int k) -> float {
            if (n < 512) return k < 64 ? w2[k * 512 + n] : 0.f;
            if (n < 1024) return (k >= 64 && k < 128) ? a2[(k - 64) * 512 + (n - 512)] : 0.f;
            if (n < 1536) return (k >= 128 && k < 256) ? g2[(k - 128) * 512 + (n - 1024)] : 0.f;
            if (n < 2048) return (l == 1 && k >= 256 && k < 288) ? v2[(k - 256) * 512 + (n - 1536)] : 0.f;
            if (n < 2176) return (k >= 288 && k < 304) ? ga2[(k - 288) * 128 + (n - 2048)] : 0.f;
            return 0.f; });
    }
}
__device__ __forceinline__ void phase_adaln(CArgs& a, lfloat* lds) {
    const int tid = ltid(); lfloat* sc = lds; lfloat* part = lds + 4096;
    for (int i = tid; i < 4096; i += 512) sc[i] = siluf_(a.in[1][i]);
    __syncthreads();
    float* mod = (float*)(a.ws + OFF_MOD);
    for (int item = lbid(); item < 2 * 192; item += gridDim.x) {
        const int l = item / 192, col0 = (item % 192) * 32, col = tid & 31, kg = tid >> 5;
        const float* W = a.in[2] + (size_t)l * DM * 6144 + col0 + col;
        float acc0 = 0.f, acc1 = 0.f, acc2 = 0.f, acc3 = 0.f;
#pragma unroll 8
        for (int kk = 0; kk < 64; ++kk) { const int k = kg * 64 + kk; const float w = W[(size_t)k * 6144];
            acc0 += sc[k] * w; acc1 += sc[1024 + k] * w; acc2 += sc[2048 + k] * w; acc3 += sc[3072 + k] * w; }
        part[(kg * 4 + 0) * 32 + col] = acc0; part[(kg * 4 + 1) * 32 + col] = acc1; part[(kg * 4 + 2) * 32 + col] = acc2; part[(kg * 4 + 3) * 32 + col] = acc3;
        __syncthreads();
        if (tid < 128) { const int b = tid >> 5; float s = a.in[3][l * 6144 + col0 + col];
#pragma unroll
            for (int g = 0; g < 16; ++g) s += part[(g * 4 + b) * 32 + col];
            mod[(l * 4 + b) * 6144 + col0 + col] = s; }
        __syncthreads();
    }
}
__device__ __forceinline__ void phase_modnorm(const float* X, const float* g, const float* mod  , int sh_off, bf16_t* out) {
    const int lane = ltid() & 63, gw = lbid() * 8 + (ltid() >> 6), ngw = gridDim.x * 8;
    for (int m = gw; m < MT; m += ngw) {
        const f32x4* xr = (const f32x4*)(X + (size_t)m * DM) + lane; f32x4 v[4]; float s = 0.f;
#pragma unroll
        for (int j = 0; j < 4; ++j) { v[j] = xr[64 * j]; s += sum4(v[j] * v[j]); }
        const float rstd = rsqrtf(wave_sum(s) * (1.f / DM) + 1e-6f);
        const float* mp = mod + (m >> 12) * 6144 + sh_off;
        uint2* o = (uint2*)(out + (size_t)m * DM) + lane;
#pragma unroll
        for (int j = 0; j < 4; ++j) { const int c = 4 * lane + 256 * j; const f32x4 gg = *(const f32x4*)(g + c), sh = *(const f32x4*)(mp + c), sc = *(const f32x4*)(mp + 1024 + c);
            o[64 * j] = pack4(v[j] * rstd * gg * (1.f + sc) + sh); }
    }
}
__device__ __forceinline__ void phase_finalnorm(float* X, const float* g) {
    const int lane = ltid() & 63, gw = lbid() * 8 + (ltid() >> 6), ngw = gridDim.x * 8;
    for (int m = gw; m < MT; m += ngw) {
        f32x4* xr = (f32x4*)(X + (size_t)m * DM) + lane; f32x4 v[4]; float s = 0.f;
#pragma unroll
        for (int j = 0; j < 4; ++j) { v[j] = xr[64 * j]; s += sum4(v[j] * v[j]); }
        const float rstd = rsqrtf(wave_sum(s) * (1.f / DM) + 1e-6f);
#pragma unroll
        for (int j = 0; j < 4; ++j) { const int c = 4 * lane + 256 * j; xr[64 * j] = v[j] * rstd * *(const f32x4*)(g + c); }
    }
}
__device__ __forceinline__ void load8(const bf16_t* p, float (&v)[8]) { const uint4 u = *(const uint4*)p;
    v[0] = __uint_as_float(u.x << 16); v[1] = __uint_as_float(u.x & 0xffff0000u); v[2] = __uint_as_float(u.y << 16); v[3] = __uint_as_float(u.y & 0xffff0000u);
    v[4] = __uint_as_float(u.z << 16); v[5] = __uint_as_float(u.z & 0xffff0000u); v[6] = __uint_as_float(u.w << 16); v[7] = __uint_as_float(u.w & 0xffff0000u); }
__device__ __forceinline__ void store8(bf16_t* p, const float (&v)[8]) { uint4 o; o.x = pg8::cvt_pk_bf16(v[0], v[1]); o.y = pg8::cvt_pk_bf16(v[2], v[3]); o.z = pg8::cvt_pk_bf16(v[4], v[5]); o.w = pg8::cvt_pk_bf16(v[6], v[7]); *(uint4*)p = o; }
__device__ __forceinline__ void phase_loramid(const bf16_t* ZX, bf16_t* A2, const bf16_t* ZR, bf16_t* BND) {
    const int gtid = lbid() * 512 + ltid(), gth = gridDim.x * 512;
    for (int i = gtid; i < 1024 * 192; i += gth) { const int row = i / 192, q8 = (i % 192) * 8;
        *(uint4*)(BND + (size_t)row * 1536 + q8) = *(const uint4*)(ZR + (size_t)(row * 16 + 15) * 1536 + q8); }
    for (int i = gtid; i < MT * 48; i += gth) { const int m = i / 48, cg = i % 48, c = cg * 8, t = m & (SEQ - 1);
        const bf16_t* zr = ZX + (size_t)m * 768; float p[8], q[8], o[8];
        int pc, qc, mode;
        if (c < 64) { pc = c; qc = 64 + c; mode = 0; } else if (c < 128) { pc = 128 + (c - 64); qc = 192 + (c - 64); mode = 1; }
        else if (c < 256) { pc = 256 + (c - 128); qc = 384 + (c - 128); mode = 2; } else if (c < 288) { pc = 512 + (c - 256); qc = 544 + (c - 256); mode = 1; }
        else if (c < 304) { pc = 576 + (c - 288); qc = 0; mode = 3; } else { pc = 0; qc = 0; mode = 4; }
        if (mode == 4) {
#pragma unroll
            for (int j = 0; j < 8; ++j) o[j] = 0.f;
        } else {
            load8(zr + pc, p);
            if (mode != 3 && t > 0) load8(zr - 768 + qc, q); else {
#pragma unroll
                for (int j = 0; j < 8; ++j) q[j] = 0.f; }
#pragma unroll
            for (int j = 0; j < 8; ++j) { const float s = p[j] + q[j]; o[j] = mode == 0 ? tanhf_(s) : (mode == 2 ? sigmoidf_(s) : s); }
        }
        store8(A2 + (size_t)m * K2 + c, o); }
}
struct RwConst { f32x4 mu_r, mu_k, mu_v, k_k, k_a, w0, a0, v0; };
__device__ __forceinline__ RwConst rw_load_const(CArgs& a, int l, int c) {
    RwConst k; const float* mu = a.in[8] + (size_t)l * 3 * 512;
    k.mu_r = *(const f32x4*)(mu + c); k.mu_k = *(const f32x4*)(mu + 512 + c); k.mu_v = *(const f32x4*)(mu + 1024 + c);
    k.k_k = *(const f32x4*)(a.in[18] + l * 512 + c); k.k_a = *(const f32x4*)(a.in[19] + l * 512 + c);
    k.w0 = *(const f32x4*)(a.in[10] + l * 512 + c); k.a0 = *(const f32x4*)(a.in[13] + l * 512 + c);
    k.v0 = l ? *(const f32x4*)(a.in[24] + c) : (f32x4){0.f, 0.f, 0.f, 0.f};
    return k;
}
struct RwTok { uint2 r, k, v, wpre, apre, vgpre, vf; };
__device__ __forceinline__ RwTok rw_load_tok(const bf16_t* ZR, const bf16_t* PRE, const bf16_t* VF, int l, int m, int c) {
    RwTok x; const uint2 z = {0u, 0u};
    const uint2* zr = (const uint2*)(ZR + (size_t)m * 1536 + c); x.r = zr[0]; x.k = zr[128]; x.v = zr[256];
    const uint2* pr = (const uint2*)(PRE + (size_t)m * N2 + c); x.wpre = pr[0]; x.apre = pr[128];
    if (l) { x.vgpre = pr[384]; x.vf = *(const uint2*)(VF + (size_t)m * 512 + c); } else { x.vgpre = z; x.vf = z; }
    return x;
}
__device__ __forceinline__ void phase_rwkv_prep(CArgs& a, int l) {
    bf16_t* ZR = (bf16_t*)(a.ws + OFF_ZR); bf16_t* PRE = (bf16_t*)(a.ws + OFF_PRE); bf16_t* VF = (bf16_t*)(a.ws + OFF_VF); const bf16_t* BND = (const bf16_t*)(a.ws + OFF_BND);
    float* BON = (float*)(a.ws + OFF_BON); float* G16 = (float*)(a.ws + OFF_G16);
    const int g16 = (lbid() * 512 + ltid()) >> 4, ng16 = gridDim.x * 32, j = ltid() & 15;
    for (int g = g16; g < 8192; g += ng16) { const int hd = g & 7, run = g >> 3, c = hd * 64 + 4 * j, mbeg = run * 16;
        const RwConst k = rw_load_const(a, l, c); const f32x4 rk = *(const f32x4*)(a.in[20] + l * 512 + c);
        uint2 rp = {0u, 0u}, kp = rp, vp = rp;
        if (mbeg & (SEQ - 1)) { const uint2* bp = (const uint2*)(BND + (size_t)(run - 1) * 1536 + c); rp = bp[0]; kp = bp[128]; vp = bp[256]; }
        RwTok cur = rw_load_tok(ZR, PRE, VF, l, mbeg, c);
        f32x4 gam = {1.f, 1.f, 1.f, 1.f};
        for (int i = 0; i < 16; ++i) { const int m = mbeg + i;
            RwTok nxt = cur; if (i < 15) nxt = rw_load_tok(ZR, PRE, VF, l, m + 1, c);
            f32x4 r = unpack4(cur.r), kq = unpack4(cur.k), v = unpack4(cur.v);
            r = r + (unpack4(rp) - r) * k.mu_r; kq = kq + (unpack4(kp) - kq) * k.mu_k; v = v + (unpack4(vp) - v) * k.mu_v;
            const f32x4 apre = k.a0 + unpack4(cur.apre), wv = k.w0 + unpack4(cur.wpre); f32x4 av, w;
#pragma unroll
            for (int q = 0; q < 4; ++q) { av[q] = sigmoidf_(apre[q]); w[q] = __expf(-__expf(-softplusf_(-wv[q]) - 0.5f)); }
            const f32x4 kkv = kq * k.k_k; const float ss = row_allreduce16(sum4(kkv * kkv));
            const float inv = 1.f / fmaxf(sqrtf(ss), 1e-12f);
            const f32x4 kk = kkv * inv, kx = kq * (1.f + (av - 1.f) * k.k_a);
            if (l) { const f32x4 vg = k.v0 + unpack4(cur.vgpre), vf = unpack4(cur.vf);
#pragma unroll
                for (int q = 0; q < 4; ++q) v[q] = v[q] + (vf[q] - v[q]) * sigmoidf_(vg[q]); }
            const float bonus = row_allreduce16(sum4(r * kx * rk));
            const f32x4 khat = kk * gam; gam = gam * w;
            f32x4 ginv;
#pragma unroll
            for (int q = 0; q < 4; ++q) ginv[q] = 1.f / gam[q];
            uint2* zr = (uint2*)(ZR + (size_t)m * 1536 + c); uint2* pr = (uint2*)(PRE + (size_t)m * N2 + c);
            zr[0] = pack4(r * gam); zr[128] = pack4(kx * ginv); const uint2 vpk = pack4(v); zr[256] = vpk;
            pr[128] = pack4(khat); pr[384] = pack4(kk * av * ginv);
            if (l == 0) *(uint2*)(VF + (size_t)m * 512 + c) = vpk;
            if (j == 0) BON[(size_t)m * 8 + hd] = bonus;
            rp = cur.r; kp = cur.k; vp = cur.v; cur = nxt; }
        *(f32x4*)(G16 + ((size_t)run * 8 + hd) * 64 + 4 * j) = gam;
    }
}
constexpr int GL_BC = 0, GL_QA = 2048, GL_QB = GL_QA + 2112, GL_QC = GL_QB + 2112, GL_KA = GL_QC + 2112, GL_KB = GL_KA + 2112, GL_KT = GL_KB + 2112,
              GL_V = GL_KT + 2112, GL_SP = GL_V + 4096, GL_ATT = GL_SP + 2048, GL_END = GL_ATT + 64 * 65;
static_assert(GL_END * 4 <= 131072, "GLA/RET LDS");
__device__ __forceinline__ float ret_log2gamma(int h) { return __log2f(1.f - exp2f(-5.f - (float)h)); }
__device__ __forceinline__ void glaret_setup(CArgs& a, int l, int type, int b, int h, int c, lfloat* lds) {
    const int tid = ltid(); const int m0 = b * SEQ + c * 64;
    const bf16_t* ZG = (const bf16_t*)(a.ws + OFF_ZG); const bf16_t* PRE = (const bf16_t*)(a.ws + OFF_PRE);
    lfloat* bc = lds + GL_BC;
    if (type == 0) {
        { const int t = tid >> 3, d4 = (tid & 7) * 4; const f32x4 x = unpack4(*(const uint2*)(PRE + (size_t)(m0 + t) * N2 + 2048 + h * 32 + d4)) + *(const f32x4*)(a.in[29] + l * 128 + h * 32 + d4);
#pragma unroll
          for (int i = 0; i < 4; ++i) bc[t * 32 + d4 + i] = -softplusf_(-x[i]) * (1.f / 16.f); }
        __syncthreads();
        {
            lfloat* seg = lds + GL_ATT; const int d = tid & 31, sg = tid >> 5;
            float v0 = bc[(sg * 4 + 0) * 32 + d], v1 = v0 + bc[(sg * 4 + 1) * 32 + d], v2 = v1 + bc[(sg * 4 + 2) * 32 + d], v3 = v2 + bc[(sg * 4 + 3) * 32 + d];
            seg[sg * 32 + d] = v3;
            __syncthreads();
            float off = 0.f;
#pragma unroll
            for (int q = 0; q < 15; ++q) off += (q < sg) ? seg[q * 32 + d] : 0.f;
            bc[(sg * 4 + 0) * 32 + d] = v0 + off; bc[(sg * 4 + 1) * 32 + d] = v1 + off; bc[(sg * 4 + 2) * 32 + d] = v2 + off; bc[(sg * 4 + 3) * 32 + d] = v3 + off;
        }
        __syncthreads();
    }
    const float scl = 0.17677669529663687f;
    {
        const int t = tid >> 3, i0 = (tid & 7) * 2; const int qoff = type ? 768 : 0, koff = type ? 896 : 128;
        const bf16_t* zr = ZG + (size_t)(m0 + t) * 1536 + h * 32 + i0;
        const unsigned q1u = *(const unsigned*)(zr + qoff), q2u = *(const unsigned*)(zr + qoff + 16), k1u = *(const unsigned*)(zr + koff), k2u = *(const unsigned*)(zr + koff + 16);
        const float l2g = ret_log2gamma(h);
#pragma unroll
        for (int u = 0; u < 2; ++u) { const int i = i0 + u;
            const float q1 = u ? __uint_as_float(q1u & 0xffff0000u) : __uint_as_float(q1u << 16), q2 = u ? __uint_as_float(q2u & 0xffff0000u) : __uint_as_float(q2u << 16);
            const float k1 = u ? __uint_as_float(k1u & 0xffff0000u) : __uint_as_float(k1u << 16), k2 = u ? __uint_as_float(k2u & 0xffff0000u) : __uint_as_float(k2u << 16);
            const int o1 = t * 33 + i, o2 = t * 33 + i + 16;
            if (type == 0) {
                const float b1 = bc[t * 32 + i], b2 = bc[t * 32 + i + 16], e1 = bc[63 * 32 + i], e2 = bc[63 * 32 + i + 16];
                const float p1 = __expf(b1), m1 = __expf(-b1), p2 = __expf(b2), m2 = __expf(-b2);
                lds[GL_QA + o1] = q1 * scl * p1; lds[GL_QB + o1] = q1 * scl * m1; lds[GL_QC + o1] = q1 * scl * p1; lds[GL_KA + o1] = k1 * m1; lds[GL_KB + o1] = k1 * p1; lds[GL_KT + o1] = k1 * __expf(e1 - b1);
                lds[GL_QA + o2] = q2 * scl * p2; lds[GL_QB + o2] = q2 * scl * m2; lds[GL_QC + o2] = q2 * scl * p2; lds[GL_KA + o2] = k2 * m2; lds[GL_KB + o2] = k2 * p2; lds[GL_KT + o2] = k2 * __expf(e2 - b2);
            } else {
                const float invf = exp2f(-(float)i * 0.8304820237218406f);
                const float ang = (float)(c * 64 + t) * invf; const float nr = rintf(ang * 0.15915494309189535f);
                float rr = fmaf(-nr, 6.28125f, ang); rr = fmaf(-nr, 1.9353071795864769e-3f, rr);
                const float cs = __cosf(rr), sn = __sinf(rr);
                const float qr1 = q1 * cs - q2 * sn, qr2 = q2 * cs + q1 * sn, kr1 = k1 * cs - k2 * sn, kr2 = k2 * cs + k1 * sn;
                const float gq = exp2f(l2g * (float)(t + 1)), gk = exp2f(l2g * (float)(63 - t));
                lds[GL_QA + o1] = qr1 * scl; lds[GL_QB + o1] = qr1 * scl; lds[GL_QC + o1] = qr1 * scl * gq; lds[GL_KA + o1] = kr1; lds[GL_KB + o1] = kr1; lds[GL_KT + o1] = kr1 * gk;
                lds[GL_QA + o2] = qr2 * scl; lds[GL_QB + o2] = qr2 * scl; lds[GL_QC + o2] = qr2 * scl * gq; lds[GL_KA + o2] = kr2; lds[GL_KB + o2] = kr2; lds[GL_KT + o2] = kr2 * gk;
            } }
    }
    {
        const int t = tid >> 3, e8 = (tid & 7) * 8; float v[8]; load8(ZG + (size_t)(m0 + t) * 1536 + (type ? 1024 : 256) + h * 64 + e8, v);
#pragma unroll
        for (int i = 0; i < 8; ++i) lds[GL_V + t * 64 + e8 + i] = v[i];
    }
    __syncthreads();
}
__device__ __forceinline__ void phase_glaret_kv(CArgs& a, int l, lfloat* lds) {
    const int tid = ltid(); float* KV = (float*)(a.ws + OFF_KV); float* DEC = (float*)(a.ws + OFF_DEC);
    for (int uid = lbid(); uid < 2048; uid += gridDim.x) {
        const int type = uid >> 10, bh = (uid >> 6) & 15, c = uid & 63, b = bh >> 2, h = bh & 3;
        glaret_setup(a, l, type, b, h, c, lds);
        const int d = tid >> 4, e4 = (tid & 15) * 4; f32x4 acc = {0.f, 0.f, 0.f, 0.f};
#pragma unroll 8
        for (int t = 0; t < 64; ++t) acc += lds[GL_KT + t * 33 + d] * *(const LAS f32x4*)(lds + GL_V + t * 64 + e4);
        *(f32x4*)(KV + ((size_t)((type * 16 + bh) * 64 + c)) * 2048 + d * 64 + e4) = acc;
        if (type == 0 && tid < 32) DEC[(bh * 64 + c) * 32 + tid] = __expf(lds[GL_BC + 63 * 32 + tid]);
        __syncthreads();
    }
}
__device__ __forceinline__ void phase_glaret_out(CArgs& a, int l, lfloat* lds) {
    const int tid = ltid(); const float* KV = (const float*)(a.ws + OFF_KV);
    const bf16_t* ZG = (const bf16_t*)(a.ws + OFF_ZG); bf16_t* PRE = (bf16_t*)(a.ws + OFF_PRE);
    for (int uid = lbid(); uid < 2048; uid += gridDim.x) {
        const int type = uid >> 10, bh = (uid >> 6) & 15, c = uid & 63, b = bh >> 2, h = bh & 3; const int m0 = b * SEQ + c * 64;
        { const f32x4 s = *(const f32x4*)(KV + ((size_t)((type * 16 + bh) * 64 + c)) * 2048 + tid * 4); *(LAS f32x4*)(lds + GL_SP + tid * 4) = s; }
        glaret_setup(a, l, type, b, h, c, lds);
        const int n = tid >> 3, g8 = (tid & 7) * 8;
        {
            float acc[8];
#pragma unroll
            for (int i = 0; i < 8; ++i) acc[i] = 0.f;
            for (int d = 0; d < 32; ++d) { const float qa = lds[GL_QA + n * 33 + d], qb = lds[GL_QB + n * 33 + d];
#pragma unroll
                for (int i = 0; i < 8; ++i) { const int m = g8 + i; acc[i] += (m <= n) ? qa * lds[GL_KA + m * 33 + d] : qb * lds[GL_KB + m * 33 + d]; } }
            const float l2g = ret_log2gamma(h);
#pragma unroll
            for (int i = 0; i < 8; ++i) { const int m = g8 + i; const float pm = type ? exp2f(l2g * (float)(m > n ? m - n : n - m)) : 1.f; lds[GL_ATT + n * 65 + m] = acc[i] * pm; }
        }
        __syncthreads();
        f32x4 o0 = {0.f, 0.f, 0.f, 0.f}, o1 = {0.f, 0.f, 0.f, 0.f};
#pragma unroll 4
        for (int m = 0; m < 64; ++m) { const float w = lds[GL_ATT + n * 65 + m]; o0 += w * *(const LAS f32x4*)(lds + GL_V + m * 64 + g8); o1 += w * *(const LAS f32x4*)(lds + GL_V + m * 64 + g8 + 4); }
#pragma unroll 4
        for (int d = 0; d < 32; ++d) { const float w = lds[GL_QC + n * 33 + d]; o0 += w * *(const LAS f32x4*)(lds + GL_SP + d * 64 + g8); o1 += w * *(const LAS f32x4*)(lds + GL_SP + d * 64 + g8 + 4); }
        float s1 = sum4(o0) + sum4(o1); s1 += __shfl_xor(s1, 1); s1 += __shfl_xor(s1, 2); s1 += __shfl_xor(s1, 4);
        const float mean = type ? s1 * (1.f / 64.f) : 0.f;
        o0 = o0 - mean; o1 = o1 - mean;
        float s2 = sum4(o0 * o0) + sum4(o1 * o1); s2 += __shfl_xor(s2, 1); s2 += __shfl_xor(s2, 2); s2 += __shfl_xor(s2, 4);
        const float rs = rsqrtf(s2 * (1.f / 64.f) + 1e-6f);
        o0 = o0 * rs; o1 = o1 * rs;
        if (type == 0) { const float* lg = a.in[30] + l * 64 + g8; o0 = o0 * *(const f32x4*)lg; o1 = o1 * *(const f32x4*)(lg + 4); }
        float gt[8]; load8(ZG + (size_t)(m0 + n) * 1536 + (type ? 1280 : 512) + h * 64 + g8, gt);
        float ov[8];
#pragma unroll
        for (int i = 0; i < 4; ++i) { ov[i] = o0[i] * siluf_(gt[i]); ov[4 + i] = o1[i] * siluf_(gt[4 + i]); }
        store8(PRE + (size_t)(m0 + n) * N2 + type * 256 + h * 64 + g8, ov);
        __syncthreads();
    }
}
__device__ __forceinline__ void phase_rwkv_out(CArgs& a, int l) {
    const bf16_t* ZR = (const bf16_t*)(a.ws + OFF_ZR); bf16_t* PRE = (bf16_t*)(a.ws + OFF_PRE); const bf16_t* YS = (const bf16_t*)(a.ws + OFF_YS); const float* BON = (const float*)(a.ws + OFF_BON);
    const int g16 = (lbid() * 512 + ltid()) >> 4, ng16 = gridDim.x * 32, j = ltid() & 15;
    for (int it = g16; it < MT * 8; it += ng16) { const int m = it >> 3, hd = it & 7, c = hd * 64 + 4 * j;
        const f32x4 v = unpack4(*(const uint2*)(ZR + (size_t)m * 1536 + 1024 + c));
        const f32x4 g4 = unpack4(*(const uint2*)(PRE + (size_t)m * N2 + 1024 + c));
        const f32x4 y4 = unpack4(*(const uint2*)(YS + (size_t)m * 512 + c));
        const float bonus = BON[(size_t)m * 8 + hd];
        const float mean = row_allreduce16(sum4(y4)) * (1.f / 64.f); const f32x4 yc = y4 - mean;
        const float var = row_allreduce16(sum4(yc * yc)) * (1.f / 64.f); const float rs = rsqrtf(var + 64e-5f);
        const f32x4 lg = *(const f32x4*)(a.in[21] + l * 512 + c), lb = *(const f32x4*)(a.in[22] + l * 512 + c);
        const f32x4 res = (yc * rs * lg + lb + bonus * v) * g4;
        *(uint2*)(PRE + (size_t)m * N2 + 512 + c) = pack4(res);
    }
}
__device__ __forceinline__ void phase_scan(CArgs& a, int l, lfloat* lds, bool do_chunks) {
    const int tid = ltid(), bid = lbid();
    {
        const int gid = bid * 512 + tid;
        if (do_chunks && gid < 65536) { const int type = gid >> 15, r = gid & 32767, bh = r >> 11, elem = r & 2047, d = elem >> 6, h = bh & 3;
            float* base = (float*)(a.ws + OFF_KV) + ((size_t)((type * 16 + bh) * 64)) * 2048 + elem; const float* dec = (const float*)(a.ws + OFF_DEC) + (size_t)(bh * 64) * 32 + d;
            const float rdec = exp2f(ret_log2gamma(h) * 64.f); float s = 0.f;
            for (int c0 = 0; c0 < 64; c0 += 8) { float kv[8], dc[8];
#pragma unroll
                for (int u = 0; u < 8; ++u) { kv[u] = base[(size_t)(c0 + u) * 2048]; dc[u] = type ? rdec : dec[(c0 + u) * 32]; }
#pragma unroll
                for (int u = 0; u < 8; ++u) { base[(size_t)(c0 + u) * 2048] = s; s = s * dc[u] + kv[u]; } }
        }
    }
    const int bh = bid & 31, rg = bid >> 5, b = bh >> 3, hd = bh & 7, wave = tid >> 6, lane = tid & 63;
    const int m0 = b * SEQ;
    const bf16_t* ZR = (const bf16_t*)(a.ws + OFF_ZR); const bf16_t* PRE = (const bf16_t*)(a.ws + OFF_PRE); bf16_t* YS = (bf16_t*)(a.ws + OFF_YS); const float* G16 = (const float*)(a.ws + OFF_G16);
    constexpr int TB = 32, NBLK = SEQ / TB, REC = 20, STEP = 16 * REC, GOFF = TB * STEP, BUF = GOFF + 128, PBUF = TB * 64, POFF = 2 * BUF;
    static_assert((2 * BUF + 2 * PBUF) * 4 <= 131072, "scan LDS");
    const bool stager = wave >= 4, scanner = wave < 2; const int st = tid - 256, j = st & 15, c = hd * 64 + 4 * j, tok0 = st >> 4;
    struct StRaw { u32x2 r, kx, v, kk, b; f32x4 g; };
    StRaw ra, rb, sa, sb;
#define ST_LOAD(dst, m) do { const bf16_t* zr_ = ZR + (size_t)(m) * 1536 + c; const bf16_t* pr_ = PRE + (size_t)(m) * N2 + c; const float* gp_ = G16 + ((size_t)((m) >> 4) * 8 + hd) * 64 + 4 * j; \
        asm volatile("global_load_dwordx2 %0, %1, off" : "=v"(dst.r) : "v"(zr_) : "memory"); \
        asm volatile("global_load_dwordx2 %0, %1, off offset:1024" : "=v"(dst.kx) : "v"(zr_) : "memory"); \
        asm volatile("global_load_dwordx2 %0, %1, off offset:2048" : "=v"(dst.v) : "v"(zr_) : "memory"); \
        asm volatile("global_load_dwordx2 %0, %1, off offset:1024" : "=v"(dst.kk) : "v"(pr_) : "memory"); \
        asm volatile("global_load_dwordx2 %0, %1, off offset:3072" : "=v"(dst.b) : "v"(pr_) : "memory"); \
        asm volatile("global_load_dwordx4 %0, %1, off" : "=v"(dst.g) : "v"(gp_) : "memory"); } while (0)
#define ST_PIN(dst) asm volatile("" : "+v"(dst.r), "+v"(dst.kx), "+v"(dst.v), "+v"(dst.kk), "+v"(dst.b), "+v"(dst.g))
#define ST_PUT(src, tok, blk) do { lfloat* q_ = lds + ((blk) & 1) * BUF + (tok) * STEP + j * REC; \
        *(LAS f32x4*)(q_) = unpack4(src.kk); *(LAS f32x4*)(q_ + 4) = unpack4(src.b); *(LAS f32x4*)(q_ + 8) = unpack4(src.kx); *(LAS f32x4*)(q_ + 12) = unpack4(src.r); *(LAS f32x4*)(q_ + 16) = unpack4(src.v); \
        if (((tok) & 15) == 0) *(LAS f32x4*)(lds + ((blk) & 1) * BUF + GOFF + ((tok) >> 4) * 64 + 4 * j) = src.g; } while (0)
#define ST_REDUCE(blk) do { const int tt_ = st >> 3, w_ = (st >> 2) & 1, rl_ = st & 3; \
        const LAS unsigned short* p_ = (const LAS unsigned short*)(lds + POFF + ((blk) & 1) * PBUF) + tt_ * 128 + w_ * 64 + rl_ * 16; \
        const pg8::u32x4 a0_ = *(const LAS pg8::u32x4*)p_, a1_ = *(const LAS pg8::u32x4*)(p_ + 8); \
        float s_ = ((bf2f(a0_[0] & 0xffffu) + bf2f(a0_[0] >> 16)) + (bf2f(a0_[1] & 0xffffu) + bf2f(a0_[1] >> 16))) + ((bf2f(a0_[2] & 0xffffu) + bf2f(a0_[2] >> 16)) + (bf2f(a0_[3] & 0xffffu) + bf2f(a0_[3] >> 16))); \
        s_ += ((bf2f(a1_[0] & 0xffffu) + bf2f(a1_[0] >> 16)) + (bf2f(a1_[1] & 0xffffu) + bf2f(a1_[1] >> 16))) + ((bf2f(a1_[2] & 0xffffu) + bf2f(a1_[2] >> 16)) + (bf2f(a1_[3] & 0xffffu) + bf2f(a1_[3] >> 16))); \
        YS[(size_t)(m0 + (blk) * TB + tt_) * 512 + hd * 64 + rg * 8 + w_ * 4 + rl_] = f2bf1(s_); } while (0)
    if (stager) { ST_LOAD(ra, m0 + tok0); ST_LOAD(rb, m0 + tok0 + 16); asm volatile("s_waitcnt vmcnt(0)" ::: "memory"); ST_PIN(ra); ST_PIN(rb); ST_PUT(ra, tok0, 0); ST_PUT(rb, tok0 + 16, 0);
        ST_LOAD(ra, m0 + TB + tok0); ST_LOAD(rb, m0 + TB + tok0 + 16); ST_LOAD(sa, m0 + 2 * TB + tok0); ST_LOAD(sb, m0 + 2 * TB + tok0 + 16); }
    LDS_BARRIER();
    typedef float f32x2s __attribute__((ext_vector_type(2)));
    f32x2s Sl = {0.f, 0.f}, Sh = {0.f, 0.f};
    const int q = lane & 15, vrow = rg * 8 + (wave & 1) * 4 + (lane >> 4);
#define SCAN_BODY(i, XA, XB) do { \
        if (stager) { \
            if ((i) + 1 < NBLK) { if ((i) + 2 < NBLK) asm volatile("s_waitcnt vmcnt(12)" ::: "memory"); else asm volatile("s_waitcnt vmcnt(0)" ::: "memory"); ST_PIN(XA); ST_PIN(XB); ST_PUT(XA, tok0, (i) + 1); ST_PUT(XB, tok0 + 16, (i) + 1); }     \
            if ((i) > 0) ST_REDUCE((i) - 1); \
            if ((i) + 3 < NBLK) { const int t3_ = m0 + ((i) + 3) * TB + tok0; ST_LOAD(XA, t3_); ST_LOAD(XB, t3_ + 16); } \
        } else if (scanner) { \
            const lfloat* buf = lds + ((i) & 1) * BUF + q * REC; const lfloat* vb = lds + ((i) & 1) * BUF + (vrow >> 2) * REC + 16 + (vrow & 3); const lfloat* gb = lds + ((i) & 1) * BUF + GOFF + 4 * q; \
            LAS unsigned short* pp = (LAS unsigned short*)(lds + POFF + ((i) & 1) * PBUF) + (wave & 1) * 64 + lane; \
            f32x4 XK[4], XB_[4], XX[4], XR[4]; float VV[4]; \
            _Pragma("unroll") for (int t_ = 0; t_ < 3; ++t_) { const lfloat* p = buf + t_ * STEP; XK[t_] = *(const LAS f32x4*)p; XB_[t_] = *(const LAS f32x4*)(p + 4); XX[t_] = *(const LAS f32x4*)(p + 8); XR[t_] = *(const LAS f32x4*)(p + 12); VV[t_] = vb[t_ * STEP]; } \
            _Pragma("unroll") for (int tt = 0; tt < TB; ++tt) { \
                if (tt + 3 < TB) { const lfloat* p = buf + (tt + 3) * STEP; const int s_ = (tt + 3) & 3; XK[s_] = *(const LAS f32x4*)p; XB_[s_] = *(const LAS f32x4*)(p + 4); XX[s_] = *(const LAS f32x4*)(p + 8); XR[s_] = *(const LAS f32x4*)(p + 12); VV[s_] = vb[(tt + 3) * STEP]; } \
                const f32x4 kk = XK[tt & 3], bb = XB_[tt & 3], kx = XX[tt & 3], r = XR[tt & 3]; const float vv = VV[tt & 3]; \
                const f32x2s kl = {kk[0], kk[1]}, kh = {kk[2], kk[3]}, bl = {bb[0], bb[1]}, bh_ = {bb[2], bb[3]}, xl = {kx[0], kx[1]}, xh = {kx[2], kx[3]}, rl = {r[0], r[1]}, rh = {r[2], r[3]}; \
                const f32x2s d2 = __builtin_elementwise_fma(Sh, kh, Sl * kl); const float dk = row_allreduce16(d2[0] + d2[1]); \
                const f32x2s vv2 = {vv, vv}, nd2 = {-dk, -dk}; \
                Sl = __builtin_elementwise_fma(nd2, bl, __builtin_elementwise_fma(vv2, xl, Sl)); Sh = __builtin_elementwise_fma(nd2, bh_, __builtin_elementwise_fma(vv2, xh, Sh)); \
                const f32x2s y2 = __builtin_elementwise_fma(Sh, rh, Sl * rl); \
                pp[tt * 128] = (unsigned short)(__float_as_uint(y2[0] + y2[1]) >> 16);     \
                if ((tt & 15) == 15) { const f32x4 g_ = *(const LAS f32x4*)(gb + (tt >> 4) * 64); Sl = Sl * (f32x2s){g_[0], g_[1]}; Sh = Sh * (f32x2s){g_[2], g_[3]}; } }     \
        } \
        LDS_BARRIER(); } while (0)
    for (int i = 0; i < NBLK; i += 2) { SCAN_BODY(i, ra, rb); SCAN_BODY(i + 1, sa, sb); }
    if (stager) ST_REDUCE(NBLK - 1);
    asm volatile("s_waitcnt vmcnt(0)" ::: "memory");
#undef SCAN_BODY
#undef ST_REDUCE
#undef ST_LOAD
#undef ST_PIN
#undef ST_PUT
}
#define GAS __attribute__((address_space(1)))
constexpr size_t OFF_BAR = 512 * 1024, BAR_BYTES = 16384;
#define XB_TMO      128
#define XB_XCNT(j)  (256  + 64 * (j))
#define XB_XSUB(j)  (1280 + 64 * (j))
#define XB_XGEN(j)  (2304 + 64 * (j))
#define XB_TOP      3328
#define XB_TOPGEN   3392
#define XCD_BAR_WORDS 3456
#define XB_SPIN_CAP (1u << 18)

__device__ __forceinline__ unsigned xb_ld(unsigned* p)              { return __hip_atomic_load(p, __ATOMIC_RELAXED, __HIP_MEMORY_SCOPE_AGENT); }
__device__ __forceinline__ unsigned xb_add(unsigned* p, unsigned v) { return __hip_atomic_fetch_add(p, v, __ATOMIC_RELAXED, __HIP_MEMORY_SCOPE_AGENT); }
__device__ __forceinline__ unsigned xb_xcc_id() { return (unsigned)__builtin_amdgcn_s_getreg((3 << 11) | 20) & 0xFu; }
#define XB_SPIN(cond, bar) do { unsigned _sp = 0; while (cond) { __builtin_amdgcn_s_sleep(1); \
    if ((++_sp & 255u) == 0u) { if (xb_ld(&(bar)[XB_TMO])) break; if (_sp > XB_SPIN_CAP) { atomicAdd(&(bar)[XB_TMO], 1u); break; } } } } while (0)

struct XcdBarrier {
    unsigned* bar; unsigned x;
    volatile LAS unsigned* st;
};

__device__ __forceinline__ XcdBarrier xcd_barrier_post(unsigned* bar, volatile LAS unsigned* st) {
    XcdBarrier b; b.bar = bar; b.x = xb_xcc_id(); b.st = st;
    if (threadIdx.x == 0) (void)xb_add(&bar[XB_XCNT(b.x)], 1u);
    return b;
}
__device__ __forceinline__ void xcd_barrier_complete(unsigned* bar, unsigned x, unsigned& nloc, unsigned& nx) {
    const unsigned G = gridDim.x * gridDim.y * gridDim.z;
    unsigned sum, cnt, mine, sp = 0u;
    for (;;) {
        sum = 0u; cnt = 0u; mine = 0u;
#pragma unroll
        for (unsigned j = 0; j < 16; ++j) { const unsigned c = xb_ld(&bar[XB_XCNT(j)]); sum += c; cnt += (c > 0u) ? 1u : 0u; mine = (j == x) ? c : mine; }
        if (sum == G) break;
        __builtin_amdgcn_s_sleep(1);
        if ((++sp & 255u) == 0u) { if (xb_ld(&bar[XB_TMO])) break; if (sp > XB_SPIN_CAP) { atomicAdd(&bar[XB_TMO], 1u); break; } }
    }
    nloc = mine > 0u ? mine : 1u; nx = cnt > 0u ? cnt : 1u;
}

__device__ __forceinline__ void xcd_barrier(const XcdBarrier& b) {
    asm volatile("s_waitcnt vmcnt(0)" ::: "memory");
    __syncthreads();
    if (threadIdx.x == 0) {
        unsigned* bar = b.bar;
        __builtin_amdgcn_s_waitcnt(0);
        unsigned nloc = b.st[0], nx = b.st[1];
        if (nloc == 0u) { xcd_barrier_complete(bar, b.x, nloc, nx); b.st[0] = nloc; b.st[1] = nx; }
        const unsigned old = xb_add(&bar[XB_XSUB(b.x)], 1u);
        const unsigned gen = old / nloc;
        if (old + 1u == (gen + 1u) * nloc) {
            __builtin_amdgcn_fence(__ATOMIC_RELEASE, "agent");
            asm volatile("s_waitcnt vmcnt(0)" ::: "memory");
            const unsigned og = xb_add(&bar[XB_TOP], 1u);
            const unsigned tg = og / nx;
            if (og + 1u == (tg + 1u) * nx) xb_add(&bar[XB_TOPGEN], 1u);
            else XB_SPIN(xb_ld(&bar[XB_TOPGEN]) == tg, bar);
            __builtin_amdgcn_fence(__ATOMIC_ACQUIRE, "agent");
            xb_add(&bar[XB_XGEN(b.x)], 1u);
            asm volatile("s_waitcnt vmcnt(0)" ::: "memory");
        } else {
            XB_SPIN(xb_ld(&bar[XB_XGEN(b.x)]) == gen, bar);
            __builtin_amdgcn_fence(__ATOMIC_ACQUIRE, "agent");
            asm volatile("s_waitcnt vmcnt(0)" ::: "memory");
        }
    }
    __syncthreads();
}

__global__ void __launch_bounds__(512, 2) mega_fwd(Args a_unused) {
    CArgs* ap0 = (CArgs*)__builtin_amdgcn_kernarg_segment_ptr();
    extern __shared__ __attribute__((aligned(16))) unsigned char lds_raw[];
    LAS unsigned char* ldsb = (LAS unsigned char*)lds_raw; lfloat* ldsf = (lfloat*)lds_raw;
    cg::grid_group grid = cg::this_grid();
    const int ph_lo = ap0->ph_lo, ph_hi = ap0->ph_hi, coop = ap0->coop;
    volatile LAS unsigned* MISC = (volatile LAS unsigned*)(ldsb + 131072);
    if (threadIdx.x < 16) MISC[threadIdx.x] = 0u;
    __syncthreads();
    const XcdBarrier xbar = xcd_barrier_post((unsigned*)(ap0->ws + OFF_BAR), MISC + 8);
    for (int ph = ph_lo; ph < ph_hi; ++ph) {
        const int l = ph / NPH, k = ph % NPH;
        const int nrep = (ph < NL * NPH && ((DUPMASK >> k) & 1)) ? 2 : 1;
        for (int rep = 0; rep < nrep; ++rep) {
        if (rep) { if (coop == 2) grid.sync(); else if (coop) xcd_barrier(xbar); }
        CArgs* ap = launder_args(ap0); CArgs& a = *ap;
        unsigned char* ws = a.ws; const int G = gridDim.x, bx = lbid();
        float* MOD = (float*)(ws + OFF_MOD);
        bf16_t* XN = (bf16_t*)(ws + OFF_XN); bf16_t* ZR = (bf16_t*)(ws + OFF_ZR); bf16_t* ZG = (bf16_t*)(ws + OFF_ZG); bf16_t* ZX = (bf16_t*)(ws + OFF_ZX);
        bf16_t* PRE = (bf16_t*)(ws + OFF_PRE); bf16_t* HFF = (bf16_t*)(ws + OFF_HFF);
        const float* mod = MOD + l * 4 * 6144;
        if (ph == NL * NPH) { phase_finalnorm(a.out, a.in[34]); }
        else if (k == 0 && (PHMASK & 1)) { if (l == 0) phase_adaln(a, ldsf); phase_weights(ap, l); __syncthreads(); phase_weights_tiled(ap, l, ldsf); }
        else if (k == 1 && (PHMASK >> 1 & 1)) { phase_modnorm(l == 0 ? a.in[0] : a.out, a.in[4] + l * DM, mod, 0, XN); }
        else if (k == 2 && (PHMASK >> 2 & 1)) { pg8::Gemm g{XN, (const bf16_t*)(ws + OFF_WIN), MT, NIN, DM, DM}; pg8::StaticOrder S; S.init(MT, NIN, G, bx); pg8::EpiIn E{ZR, ZG, ZX};
            pg8::gemm_phase<pg8::EpiIn, pg8::StaticOrder, true, true>(ldsb, g, S, E); }
        else if (k == 3 && (PHMASK >> 3 & 1)) { phase_loramid(ZX, XN, ZR, (bf16_t*)(ws + OFF_BND)); }
        else if (k == 4 && (PHMASK >> 4 & 1)) { pg8::Gemm g{XN, (const bf16_t*)(ws + OFF_W2L), MT, N2, K2, K2}; pg8::StaticOrder S; S.init(MT, N2, G, bx); pg8::EpiPlain E{PRE, N2};
            pg8::gemm_phase<pg8::EpiPlain, pg8::StaticOrder, true, true>(ldsb, g, S, E); }
        else if (k == 5 && (PHMASK >> 5 & 1)) { phase_rwkv_prep(a, l); phase_glaret_kv(a, l, ldsf); }
        else if (k == 6 && (PHMASK >> 6 & 1)) { phase_scan(a, l, ldsf, rep == 0); }
        else if (k == 7 && (PHMASK >> 7 & 1)) { phase_rwkv_out(a, l); phase_glaret_out(a, l, ldsf); }
        else if (k == 8 && (PHMASK >> 8 & 1)) { pg8::Gemm g{PRE, (const bf16_t*)(ws + OFF_WO), MT, DM, DM, N2}; pg8::StaticOrder S; S.init(MT, DM, G, bx); pg8::EpiRes E{l == 0 ? a.in[0] : a.out, a.out, mod + 2048};
            pg8::gemm_phase<pg8::EpiRes, pg8::StaticOrder, true, true>(ldsb, g, S, E); }
        else if (k == 9 && (PHMASK >> 9 & 1)) { phase_modnorm(a.out, a.in[5] + l * DM, mod, 3072, XN); }
        else if (k == 10 && (PHMASK >> 10 & 1)) { pg8::Gemm g{XN, (const bf16_t*)(ws + OFF_WGU), MT, NGU, DM, DM}; pg8::StaticOrder S; S.init(MT, NGU, G, bx); pg8::EpiSwiGLU E{HFF};
            pg8::gemm_phase<pg8::EpiSwiGLU, pg8::StaticOrder, true, true>(ldsb, g, S, E); }
        else if (PHMASK >> 11 & 1) { pg8::Gemm g{HFF, (const bf16_t*)(ws + OFF_WD), MT, DM, DFF, DFF}; pg8::StaticOrder S; S.init(MT, DM, G, bx); pg8::EpiRes E{a.out, a.out, mod + 5120};
            pg8::gemm_phase<pg8::EpiRes, pg8::StaticOrder, true, true>(ldsb, g, S, E); }
        }
        if (ph + 1 < ph_hi) { if (coop == 2) grid.sync(); else if (coop) { xcd_barrier(xbar); for (int xs = 0; xs < EXTRA_SYNCS; ++xs) xcd_barrier(xbar); } }
    }
}

constexpr int LDS_BYTES = 147456;
extern "C" void kernel_launch(void* const* d_in, const int* in_sizes, int n_in, void* d_out, int out_size, void* d_ws, size_t ws_size, hipStream_t stream) {
    static int grid = 0;
    if (grid == 0) {
        if (n_in != 35 || out_size != MT * DM || ws_size < OFF_END) { fprintf(stderr, "kernel_launch: unexpected problem (n_in %d out %d ws %zu)\n", n_in, out_size, ws_size); grid = -1; return; }
        int dev = 0, cus = 0, per_cu = 0;
        hipGetDevice(&dev); hipDeviceGetAttribute(&cus, hipDeviceAttributeMultiprocessorCount, dev);
        hipFuncSetAttribute((const void*)mega_fwd, hipFuncAttributeMaxDynamicSharedMemorySize, LDS_BYTES);
        hipOccupancyMaxActiveBlocksPerMultiprocessor(&per_cu, (const void*)mega_fwd, 512, LDS_BYTES);
        if (per_cu < 1) { fprintf(stderr, "kernel_launch: occupancy query says %d blocks per CU\n", per_cu); per_cu = 1; }
        (void)hipGetLastError();
        grid = cus;
    }
    if (grid < 0) return;
    Args a{};
    for (int i = 0; i < 35; ++i) a.in[i] = (const float*)d_in[i];
    a.out = (float*)d_out; a.ws = (unsigned char*)d_ws;
#if MK_MULTI
    for (int ph = 0; ph <= NL * NPH; ++ph) { a.ph_lo = ph; a.ph_hi = ph + 1; a.coop = 0; hipLaunchKernelGGL(mega_fwd, dim3(grid), dim3(512), LDS_BYTES, stream, a); }
#else
    a.ph_lo = 0; a.ph_hi = NL * NPH + 1; a.coop = 1;
    if (hipMemsetAsync((unsigned char*)d_ws + OFF_BAR, 0, BAR_BYTES, stream) != hipSuccess) { fprintf(stderr, "memset failed\n"); return; }
    void* args[] = {&a};
    hipError_t e = hipLaunchCooperativeKernel((const void*)mega_fwd, dim3(grid), dim3(512), args, LDS_BYTES, stream);
    if (e != hipSuccess) fprintf(stderr, "cooperative launch failed: %s (grid %d)\n", hipGetErrorString(e), grid);
#endif
}
```

```cpp
#include <hip/hip_runtime.h>
#include <hip/hip_cooperative_groups.h>
#include <cstdio>
#include <cstdint>
namespace cg = cooperative_groups;
#ifndef MK_MULTI
#define MK_MULTI 0
#endif
__device__ __forceinline__ int ltid() { int t = threadIdx.x; asm volatile("" : "+v"(t)); return t; }
__device__ __forceinline__ int lbid() { int b = blockIdx.x; asm volatile("" : "+s"(b)); return b; }
namespace pg8 {
#define PG8_LAS __attribute__((address_space(3)))
typedef unsigned short bf16_t;
typedef short bf16x8 __attribute__((ext_vector_type(8)));
typedef float f32x4 __attribute__((ext_vector_type(4)));
typedef unsigned u32x4 __attribute__((ext_vector_type(4)));
constexpr int BM = 256, BK = 64, HALF = 128, HTB = HALF * BK * 2  , STAGE_BYTES = 8 * HTB, NXCD = 8, WGM = 8;

__host__ __device__ __forceinline__ int lds_byte(int r, int c) { const int st = (r >> 4) * 2 + (c >> 5), rr = r & 15, cc = c & 31, ob = rr * 64 + cc * 2; return st * 1024 + (ob ^ (((ob >> 9) & 1) << 5)); }
__host__ __device__ __forceinline__ void stage_rc(int b, int& R, int& C) { const int st = b / 1024, sb = b % 1024, swz = sb ^ (((sb >> 9) & 1) << 5); R = (st >> 1) * 16 + swz / 64; C = (st & 1) * 32 + (swz % 64) / 2; }
__host__ __device__ __forceinline__ int perm32(int rho) { const int n = rho >> 4, i = rho & 15; return 8 * (i >> 2) + 4 * n + (i & 3); }

struct Unit { int pm, pn; };
struct Gemm { const bf16_t* A; const bf16_t* Bt; int M, N, K, lda; };

struct StaticOrder {
    int nM, nN, nwg, G, c;
    __host__ __device__ void init(int M, int N, int G_, int c_) { nM = M / BM; nN = N / BM; nwg = nM * nN; G = G_; c = c_; }
    __host__ __device__ bool next(int i, Unit& u) const {
        const long L = (long)i * G + c; if (L >= nwg) return false;
        int wgid = (int)L; { const int q = nwg / NXCD, r = nwg % NXCD, xcd = wgid % NXCD, off = wgid / NXCD; wgid = (xcd < r ? xcd * (q + 1) : r * (q + 1) + (xcd - r) * q) + off; }
        const int nig = WGM * nN, gid = wgid / nig, fm = gid * WGM, gsz = (nM - fm) < WGM ? (nM - fm) : WGM;
        u.pm = fm + ((wgid % nig) % gsz); u.pn = (wgid % nig) / gsz; return true;
    }
    __device__ __forceinline__ void a_ready(const Unit&) const {}
    __device__ __forceinline__ void done(const Unit&) const {}
};

__device__ __forceinline__ unsigned cvt_pk_bf16(float lo, float hi) { unsigned r; asm volatile("v_cvt_pk_bf16_f32 %0, %1, %2" : "=v"(r) : "v"(lo), "v"(hi)); return r; }
typedef float f32x2 __attribute__((ext_vector_type(2)));
__device__ __forceinline__ f32x2 gelu_pk(f32x2 v) {
    const f32x2 av = __builtin_elementwise_abs(v), d = av * 0.2316418882f + 1.0f;
    f32x2 t; t.x = __builtin_amdgcn_rcpf(d.x); t.y = __builtin_amdgcn_rcpf(d.y);
    f32x2 q = t * 0.5307027145f + (-0.7265760135f); q = q * t + 0.7107068705f; q = q * t + (-0.142248368f); q = q * t + 0.127414796f; q = q * t;
    const f32x2 s = (v * v) * (-0.72134752044f);
    f32x2 e; e.x = __builtin_amdgcn_exp2f(s.x); e.y = __builtin_amdgcn_exp2f(s.y);
    const f32x2 m = v * (q * e), r = v - m;
    f32x2 o; o.x = v.x < 0.f ? m.x : r.x; o.y = v.y < 0.f ? m.y : r.y; return o;
}

template <int ACT  > struct EpiBf16 {
    static constexpr bool PERM = true, AFTER_DRAIN = false; static_assert(ACT == 0 || ACT == 1, "EpiBf16: ACT is 0 (none) or 1 (gelu_pk)");
    bf16_t* O; int ldc; const float* bias; int split_cols; size_t split_stride; float scale0;
    __device__ __forceinline__ void operator()(const f32x4 (&acc)[2][2][4][2], const Unit& u, int wr, int wc, int fr, int fq) const {
        const int row0 = u.pm * BM + wr * 64 + fr; int colt = u.pn * BM; bf16_t* base = O;
        float sc = 1.f; if (split_cols) { const int t = colt / split_cols; base += (size_t)t * split_stride; colt -= t * split_cols; if (t == 0) sc = scale0; }
        const int col0 = colt + wc * 32 + 8 * fq, bcol0 = u.pn * BM + wc * 32 + 8 * fq;
        f32x4 bv[2][2];
#pragma unroll
        for (int bj = 0; bj < 2; ++bj)
#pragma unroll
            for (int n = 0; n < 2; ++n) bv[bj][n] = bias ? *(const f32x4*)(bias + bcol0 + bj * HALF + 4 * n) : (f32x4){0.f, 0.f, 0.f, 0.f};
#pragma unroll
        for (int ai = 0; ai < 2; ++ai)
#pragma unroll
            for (int m = 0; m < 4; ++m) { bf16_t* rowp = base + (size_t)(row0 + ai * HALF + m * 16) * ldc + col0;
#pragma unroll
                for (int bj = 0; bj < 2; ++bj) { f32x4 v0 = acc[ai][bj][m][0] + bv[bj][0], v1 = acc[ai][bj][m][1] + bv[bj][1];
                    if (ACT == 1) { f32x2 a = gelu_pk((f32x2){v0[0], v0[1]}), b = gelu_pk((f32x2){v0[2], v0[3]}), c = gelu_pk((f32x2){v1[0], v1[1]}), d = gelu_pk((f32x2){v1[2], v1[3]});
                        v0 = (f32x4){a.x, a.y, b.x, b.y}; v1 = (f32x4){c.x, c.y, d.x, d.y}; }
                    v0 = v0 * sc; v1 = v1 * sc; u32x4 w; w.x = cvt_pk_bf16(v0[0], v0[1]); w.y = cvt_pk_bf16(v0[2], v0[3]); w.z = cvt_pk_bf16(v1[0], v1[1]); w.w = cvt_pk_bf16(v1[2], v1[3]);
                    *(u32x4*)(rowp + bj * HALF) = w; } }
    }
};
template <class Epi, class Sched, bool ALIGN_EPI = false, bool SP2 = false>
__device__ __forceinline__ void gemm_phase(PG8_LAS unsigned char* lds, const Gemm g, const Sched& S, const Epi& E) {
    const int tid = ltid(), wid = __builtin_amdgcn_readfirstlane(tid >> 6), lane = tid & 63, wr = wid >> 2, wc = wid & 3, fr = lane & 15, fq = lane >> 4;
    const int K = g.K, nt = K / BK;
    unsigned voffA[2], voffB[2];
#pragma unroll
    for (int i = 0; i < 2; ++i) { int R, C; stage_rc(tid * 16 + i * 8192, R, C); const int Rb = Epi::PERM ? ((R & ~31) + perm32(R & 31)) : R;
        voffA[i] = (unsigned)(R * g.lda + C) * 2u; voffB[i] = (unsigned)(Rb * K + C) * 2u; }
    const size_t kstep = (size_t)(BK * 2);
    const size_t hstep = (size_t)HALF * K * 2;
    const size_t tstep = 2 * hstep; const size_t hstepA = (size_t)HALF * g.lda * 2, tstepA = 2 * hstepA;
    const unsigned ldsw = (unsigned)wid * 1024u;
    const int aoff = lds_byte(wr * 64 + fr, fq * 8), boff = lds_byte(wc * 32 + fr, fq * 8);
#define PG8_SA(b, h) (((b) * 2 + (h)) * HTB)
#define PG8_SB(b, h) ((4 + (b) * 2 + (h)) * HTB)
#define PG8_STAGE(bufoff, gbase, voff) do { _Pragma("unroll") for (int _i = 0; _i < 2; ++_i) \
        __builtin_amdgcn_global_load_lds((const unsigned*)((const char*)(gbase) + (voff)[_i]), (PG8_LAS unsigned*)(lds + (bufoff) + ldsw + _i * 8192), 16, 0, 0); } while (0)
#define PG8_LDA(dst, b, h) do { _Pragma("unroll") for (int m = 0; m < 4; ++m) _Pragma("unroll") for (int k = 0; k < 2; ++k) dst[m][k] = *(const PG8_LAS bf16x8*)(lds + PG8_SA(b, h) + aoff + m * 2048 + k * 1024); } while (0)
#define PG8_LDB(dst, b, h) do { _Pragma("unroll") for (int n = 0; n < 2; ++n) _Pragma("unroll") for (int k = 0; k < 2; ++k) dst[n][k] = *(const PG8_LAS bf16x8*)(lds + PG8_SB(b, h) + boff + n * 2048 + k * 1024); } while (0)
#define PG8_MMA(ai, bj, At, Bt) do { __builtin_amdgcn_s_setprio(1); _Pragma("unroll") for (int m = 0; m < 4; ++m) _Pragma("unroll") for (int n = 0; n < 2; ++n) _Pragma("unroll") for (int k = 0; k < 2; ++k) \
        acc[ai][bj][m][n] = __builtin_amdgcn_mfma_f32_16x16x32_bf16(Bt[n][k], At[m][k], acc[ai][bj][m][n], 0, 0, 0); __builtin_amdgcn_s_setprio(0); } while (0)
#define PG8_WAIT_V(n) asm volatile("s_waitcnt vmcnt(" #n ")" ::: "memory")
#define PG8_WAIT_L(n) asm volatile("s_waitcnt lgkmcnt(" #n ")" ::: "memory")
#define PG8_BAR __builtin_amdgcn_s_barrier()
#define PG8_SCHED __builtin_amdgcn_sched_barrier(0)
    Unit cur, nxt; int ui = 0;
    if (!S.next(0, cur)) return;
    f32x4 acc[2][2][4][2];
#pragma unroll
    for (int a = 0; a < 2; ++a)
#pragma unroll
        for (int b = 0; b < 2; ++b)
#pragma unroll
            for (int m = 0; m < 4; ++m)
#pragma unroll
                for (int n = 0; n < 2; ++n) acc[a][b][m][n] = (f32x4){0.f, 0.f, 0.f, 0.f};
    bf16x8 At[4][2], B0[2][2], B1[2][2];
    const char* cA = (const char*)g.A + (size_t)cur.pm * tstepA; const char* cB = (const char*)g.Bt + (size_t)cur.pn * tstep;
    S.a_ready(cur);
    if constexpr (SP2) {
        PG8_STAGE(PG8_SB(0, 0), cB, voffB); PG8_STAGE(PG8_SB(0, 1), cB + hstep, voffB); PG8_STAGE(PG8_SA(0, 0), cA, voffA); PG8_STAGE(PG8_SA(0, 1), cA + hstepA, voffA);
        if (wr == 1) PG8_BAR;
        PG8_WAIT_V(2); PG8_BAR;
        PG8_STAGE(PG8_SB(1, 0), cB + kstep, voffB); PG8_STAGE(PG8_SA(1, 0), cA + kstep, voffA); PG8_STAGE(PG8_SB(1, 1), cB + hstep + kstep, voffB);
        PG8_WAIT_V(6); PG8_BAR;
    } else {
        PG8_STAGE(PG8_SB(0, 0), cB, voffB); PG8_STAGE(PG8_SA(0, 0), cA, voffA); PG8_STAGE(PG8_SB(0, 1), cB + hstep, voffB); PG8_STAGE(PG8_SA(0, 1), cA + hstepA, voffA);
        if (wr == 1) PG8_BAR;
        PG8_WAIT_V(4); PG8_BAR;
        PG8_STAGE(PG8_SB(1, 0), cB + kstep, voffB); PG8_STAGE(PG8_SA(1, 0), cA + kstep, voffA); PG8_STAGE(PG8_SB(1, 1), cB + hstep + kstep, voffB);
        PG8_WAIT_V(6); PG8_BAR;
    }
    for (;;) {
        const bool has_next = S.next(ui + 1, nxt);
        const char* nA = has_next ? (const char*)g.A + (size_t)nxt.pm * tstepA : cA; const char* nB = has_next ? (const char*)g.Bt + (size_t)nxt.pn * tstep : cB;
        _Pragma("unroll 1") for (int t = 0; t < nt; t += 2) {
            const bool last = (t == nt - 2);
            const char* a1 = cA + (size_t)(t + 1) * kstep;
            const char* a2 = last ? nA : cA + (size_t)(t + 2) * kstep; const char* b2 = last ? nB : cB + (size_t)(t + 2) * kstep;
            const char* a3 = a2 + kstep; const char* b3 = b2 + kstep;
            if (last && has_next) S.a_ready(nxt);
            if constexpr (SP2) {
            PG8_LDB(B0, 0, 0); PG8_LDB(B1, 0, 1); PG8_SCHED; PG8_LDA(At, 0, 0); PG8_STAGE(PG8_SA(1, 1), a1 + hstepA, voffA);
            PG8_WAIT_V(8); PG8_WAIT_L(0); PG8_BAR; PG8_MMA(0, 0, At, B0); PG8_MMA(0, 1, At, B1); PG8_BAR; PG8_SCHED;
            PG8_LDA(At, 0, 1); PG8_STAGE(PG8_SB(0, 0), b2, voffB); PG8_STAGE(PG8_SB(0, 1), b2 + hstep, voffB); PG8_STAGE(PG8_SA(0, 0), a2, voffA);
            PG8_WAIT_V(8); PG8_WAIT_L(0); PG8_BAR; PG8_MMA(1, 0, At, B0); PG8_MMA(1, 1, At, B1); PG8_BAR; PG8_SCHED;
            PG8_LDB(B0, 1, 0); PG8_LDB(B1, 1, 1); PG8_SCHED; PG8_LDA(At, 1, 0); PG8_STAGE(PG8_SA(0, 1), a2 + hstepA, voffA);
            PG8_WAIT_V(8); PG8_WAIT_L(0); PG8_BAR; PG8_MMA(0, 0, At, B0); PG8_MMA(0, 1, At, B1); PG8_BAR; PG8_SCHED;
            PG8_LDA(At, 1, 1); PG8_STAGE(PG8_SB(1, 0), b3, voffB); PG8_STAGE(PG8_SB(1, 1), b3 + hstep, voffB); PG8_STAGE(PG8_SA(1, 0), a3, voffA);
            PG8_WAIT_V(8); PG8_WAIT_L(0); PG8_BAR; PG8_MMA(1, 0, At, B0); PG8_MMA(1, 1, At, B1); PG8_BAR; PG8_SCHED;
            } else {
            PG8_LDB(B0, 0, 0); PG8_SCHED; PG8_LDA(At, 0, 0); PG8_STAGE(PG8_SA(1, 1), a1 + hstepA, voffA);
            PG8_WAIT_L(8); PG8_BAR; PG8_WAIT_L(0); PG8_MMA(0, 0, At, B0); PG8_BAR; PG8_SCHED;
            PG8_LDB(B1, 0, 1); PG8_STAGE(PG8_SB(0, 0), b2, voffB);
            PG8_BAR; PG8_WAIT_L(0); PG8_MMA(0, 1, At, B1); PG8_BAR;
            PG8_LDA(At, 0, 1); PG8_STAGE(PG8_SA(0, 0), a2, voffA);
            PG8_BAR; PG8_WAIT_L(0); PG8_MMA(1, 0, At, B0); PG8_BAR; PG8_SCHED;
            PG8_STAGE(PG8_SB(0, 1), b2 + hstep, voffB);
            PG8_WAIT_V(6); PG8_BAR; PG8_MMA(1, 1, At, B1); PG8_BAR;
            PG8_LDB(B0, 1, 0); PG8_SCHED; PG8_LDA(At, 1, 0); PG8_STAGE(PG8_SA(0, 1), a2 + hstepA, voffA);
            PG8_WAIT_L(8); PG8_BAR; PG8_WAIT_L(0); PG8_MMA(0, 0, At, B0); PG8_BAR; PG8_SCHED;
            PG8_LDB(B1, 1, 1); PG8_STAGE(PG8_SB(1, 0), b3, voffB);
            PG8_BAR; PG8_WAIT_L(0); PG8_MMA(0, 1, At, B1); PG8_BAR;
            PG8_LDA(At, 1, 1); PG8_STAGE(PG8_SA(1, 0), a3, voffA);
            PG8_BAR; PG8_WAIT_L(0); PG8_MMA(1, 0, At, B0); PG8_BAR; PG8_SCHED;
            PG8_STAGE(PG8_SB(1, 1), b3 + hstep, voffB);
            PG8_WAIT_V(6); PG8_BAR; PG8_MMA(1, 1, At, B1); PG8_BAR;
            }
        }
        if constexpr (ALIGN_EPI) { if (wr == 0) PG8_BAR; }
        if constexpr (!Epi::AFTER_DRAIN) { E(acc, cur, wr, wc, fr, fq); S.done(cur); }
        if (!has_next) break;
#pragma unroll
        for (int a = 0; a < 2; ++a)
#pragma unroll
            for (int b = 0; b < 2; ++b)
#pragma unroll
                for (int m = 0; m < 4; ++m)
#pragma unroll
                    for (int n = 0; n < 2; ++n) acc[a][b][m][n] = (f32x4){0.f, 0.f, 0.f, 0.f};
        cur = nxt; cA = nA; cB = nB; ++ui;
        if constexpr (ALIGN_EPI) { if (wr == 1) PG8_BAR; }
    }
    PG8_WAIT_V(0);
    if constexpr (!ALIGN_EPI) { if (wr == 0) PG8_BAR; }
    PG8_BAR;
    if constexpr (Epi::AFTER_DRAIN) { E.fused(acc, cur, wr, wc, fr, fq, lds, wid, lane); S.done(cur); }
#undef PG8_SA
#undef PG8_SB
#undef PG8_STAGE
#undef PG8_LDA
#undef PG8_LDB
#undef PG8_MMA
#undef PG8_WAIT_V
#undef PG8_WAIT_L
#undef PG8_BAR
#undef PG8_SCHED
}
}

#define LAS __attribute__((address_space(3)))
typedef unsigned short bf16_t;
typedef float f32x4 __attribute__((ext_vector_type(4)));
typedef LAS float lfloat;

constexpr int NB = 4, SEQ = 4096, DM = 1024, MT = NB * SEQ, NL = 2;
constexpr int NIN = 3840, K2 = 384, N2 = 2304, DFF = 2816, NGU = 5632;
#ifndef EXTRA_SYNCS
#define EXTRA_SYNCS 0
#endif
#ifndef SCAN_TWICE
#define SCAN_TWICE 0
#endif
#ifndef XTRA_LDS
#define XTRA_LDS 0
#endif
#ifndef DUPMASK
#define DUPMASK 0
#endif
#ifndef PHMASK
#define PHMASK 0xfff
#endif
constexpr int NPH = 12;
constexpr size_t MiB = 1u << 20;
constexpr size_t OFF_MOD = 0, OFF_DEC = 1 * MiB, OFF_W = 2 * MiB;
constexpr size_t OFF_WIN = OFF_W, OFF_WO = OFF_WIN + (size_t)NIN * DM * 2, OFF_WGU = OFF_WO + (size_t)DM * DM * 2,
                 OFF_WD = OFF_WGU + (size_t)NGU * DM * 2, OFF_W2L = OFF_WD + (size_t)DM * DFF * 2, OFF_WEND = OFF_W2L + (size_t)N2 * K2 * 2;
constexpr size_t OFF_VF = 30 * MiB, OFF_XN = 46 * MiB, OFF_KV = OFF_XN, OFF_YS = OFF_XN + 16 * MiB;
constexpr size_t OFF_ZR = 78 * MiB, OFF_ZG = 126 * MiB, OFF_HFF = OFF_ZR, OFF_PRE = 174 * MiB, OFF_ZX = OFF_PRE, OFF_BND = 246 * MiB, OFF_BON = 250 * MiB, OFF_G16 = 251 * MiB, OFF_END = 253 * MiB;
static_assert(OFF_WEND <= OFF_VF, "weights fit");

struct Args { const float* in[35]; float* out; unsigned char* ws; int ph_lo, ph_hi, coop, pad; };
typedef const __attribute__((address_space(4))) Args CArgs;
__device__ __forceinline__ CArgs* launder_args(CArgs* p) { asm volatile("" : "+s"(p)); return p; }

__device__ __forceinline__ float bf2f(unsigned u16) { return __uint_as_float(u16 << 16); }
__device__ __forceinline__ f32x4 unpack4(uint2 u) { return (f32x4){__uint_as_float(u.x << 16), __uint_as_float(u.x & 0xffff0000u), __uint_as_float(u.y << 16), __uint_as_float(u.y & 0xffff0000u)}; }
typedef unsigned u32x2 __attribute__((ext_vector_type(2)));
__device__ __forceinline__ f32x4 unpack4(u32x2 u) { return (f32x4){__uint_as_float(u[0] << 16), __uint_as_float(u[0] & 0xffff0000u), __uint_as_float(u[1] << 16), __uint_as_float(u[1] & 0xffff0000u)}; }
__device__ __forceinline__ uint2 pack4(f32x4 v) { uint2 r; r.x = pg8::cvt_pk_bf16(v[0], v[1]); r.y = pg8::cvt_pk_bf16(v[2], v[3]); return r; }
__device__ __forceinline__ unsigned short f2bf1(float v) { return (unsigned short)(pg8::cvt_pk_bf16(v, 0.f) & 0xffffu); }
__device__ __forceinline__ float sigmoidf_(float x) { return __builtin_amdgcn_rcpf(1.f + __expf(-x)); }
__device__ __forceinline__ float siluf_(float x) { return x * sigmoidf_(x); }
__device__ __forceinline__ float tanhf_(float x) { return 1.f - 2.f * __builtin_amdgcn_rcpf(__expf(2.f * x) + 1.f); }
__device__ __forceinline__ float softplusf_(float z) { return fmaxf(z, 0.f) + __logf(1.f + __expf(-fabsf(z))); }
__device__ __forceinline__ float row_allreduce16(float v) {
    v += __int_as_float(__builtin_amdgcn_update_dpp(0, __float_as_int(v), 0x128, 0xf, 0xf, false));
    v += __int_as_float(__builtin_amdgcn_update_dpp(0, __float_as_int(v), 0x124, 0xf, 0xf, false));
    v += __int_as_float(__builtin_amdgcn_update_dpp(0, __float_as_int(v), 0x122, 0xf, 0xf, false));
    v += __int_as_float(__builtin_amdgcn_update_dpp(0, __float_as_int(v), 0x121, 0xf, 0xf, false));
    return v;
}
__device__ __forceinline__ float row_allreduce32(float v) {
    v = row_allreduce16(v);
    const auto rr = __builtin_amdgcn_permlane32_swap(__float_as_uint(v), __float_as_uint(v), false, false);
    return __uint_as_float(rr[0]) + __uint_as_float(rr[1]);
}
__device__ __forceinline__ float wave_sum(float v) {
#pragma unroll
    for (int o = 1; o < 64; o <<= 1) v += __shfl_xor(v, o);
    return v;
}
#define LDS_BARRIER() do { asm volatile("s_waitcnt lgkmcnt(0)" ::: "memory"); __builtin_amdgcn_s_barrier(); asm volatile("" ::: "memory"); } while (0)
__device__ __forceinline__ float sum4(f32x4 v) { return (v[0] + v[1]) + (v[2] + v[3]); }

namespace pg8 {
struct EpiIn {
    static constexpr bool PERM = true, AFTER_DRAIN = false;
    bf16_t *ZR, *ZG, *ZX;
    __device__ __forceinline__ void operator()(const f32x4 (&acc)[2][2][4][2], const Unit& u, int wr, int wc, int fr, int fq) const {
        int colt = u.pn * BM; bf16_t* base; int ldc;
        if (colt < 1536) { base = ZR; ldc = 1536; } else if (colt < 3072) { base = ZG; ldc = 1536; colt -= 1536; } else { base = ZX; ldc = 768; colt -= 3072; }
        const int row0 = u.pm * BM + wr * 64 + fr, col0 = colt + wc * 32 + 8 * fq;
#pragma unroll
        for (int ai = 0; ai < 2; ++ai)
#pragma unroll
            for (int m = 0; m < 4; ++m) { bf16_t* rowp = base + (size_t)(row0 + ai * HALF + m * 16) * ldc + col0;
#pragma unroll
                for (int bj = 0; bj < 2; ++bj) { const f32x4 v0 = acc[ai][bj][m][0], v1 = acc[ai][bj][m][1];
                    u32x4 w; w.x = cvt_pk_bf16(v0[0], v0[1]); w.y = cvt_pk_bf16(v0[2], v0[3]); w.z = cvt_pk_bf16(v1[0], v1[1]); w.w = cvt_pk_bf16(v1[2], v1[3]);
                    *(u32x4*)(rowp + bj * HALF) = w; } }
    }
};
struct EpiPlain {
    static constexpr bool PERM = true, AFTER_DRAIN = false;
    bf16_t* O; int ldc;
    __device__ __forceinline__ void operator()(const f32x4 (&acc)[2][2][4][2], const Unit& u, int wr, int wc, int fr, int fq) const {
        const int row0 = u.pm * BM + wr * 64 + fr, col0 = u.pn * BM + wc * 32 + 8 * fq;
#pragma unroll
        for (int ai = 0; ai < 2; ++ai)
#pragma unroll
            for (int m = 0; m < 4; ++m) { bf16_t* rowp = O + (size_t)(row0 + ai * HALF + m * 16) * ldc + col0;
#pragma unroll
                for (int bj = 0; bj < 2; ++bj) { const f32x4 v0 = acc[ai][bj][m][0], v1 = acc[ai][bj][m][1];
                    u32x4 w; w.x = cvt_pk_bf16(v0[0], v0[1]); w.y = cvt_pk_bf16(v0[2], v0[3]); w.z = cvt_pk_bf16(v1[0], v1[1]); w.w = cvt_pk_bf16(v1[2], v1[3]);
                    *(u32x4*)(rowp + bj * HALF) = w; } }
    }
};
struct EpiRes {
    static constexpr bool PERM = true, AFTER_DRAIN = false;
    const float* xin; float* xout; const float* gate;
    __device__ __forceinline__ void operator()(const f32x4 (&acc)[2][2][4][2], const Unit& u, int wr, int wc, int fr, int fq) const {
        const int b = u.pm >> 4; const float* gp = gate + b * 6144;
        const int row0 = u.pm * BM + wr * 64 + fr, col0 = u.pn * BM + wc * 32 + 8 * fq;
        f32x4 gv[2][2];
#pragma unroll
        for (int bj = 0; bj < 2; ++bj)
#pragma unroll
            for (int n = 0; n < 2; ++n) gv[bj][n] = *(const f32x4*)(gp + col0 + bj * HALF + 4 * n);
#pragma unroll
        for (int ai = 0; ai < 2; ++ai)
#pragma unroll
            for (int m = 0; m < 4; ++m) { const size_t off = (size_t)(row0 + ai * HALF + m * 16) * 1024 + col0;
#pragma unroll
                for (int bj = 0; bj < 2; ++bj)
#pragma unroll
                    for (int n = 0; n < 2; ++n) { const f32x4 xi = *(const f32x4*)(xin + off + bj * HALF + 4 * n);
                        *(f32x4*)(xout + off + bj * HALF + 4 * n) = xi + gv[bj][n] * acc[ai][bj][m][n]; } }
    }
};
struct EpiSwiGLU {
    static constexpr bool PERM = true, AFTER_DRAIN = false;
    bf16_t* H;
    __device__ __forceinline__ void operator()(const f32x4 (&acc)[2][2][4][2], const Unit& u, int wr, int wc, int fr, int fq) const {
        const int row0 = u.pm * BM + wr * 64 + fr, col0 = u.pn * HALF + wc * 32 + 8 * fq;
#pragma unroll
        for (int ai = 0; ai < 2; ++ai)
#pragma unroll
            for (int m = 0; m < 4; ++m) { bf16_t* rowp = H + (size_t)(row0 + ai * HALF + m * 16) * DFF + col0;
                f32x4 g0 = acc[ai][0][m][0], g1 = acc[ai][0][m][1]; const f32x4 u0 = acc[ai][1][m][0], u1 = acc[ai][1][m][1];
#pragma unroll
                for (int i = 0; i < 4; ++i) { g0[i] = siluf_(g0[i]) * u0[i]; g1[i] = siluf_(g1[i]) * u1[i]; }
                u32x4 w; w.x = cvt_pk_bf16(g0[0], g0[1]); w.y = cvt_pk_bf16(g0[2], g0[3]); w.z = cvt_pk_bf16(g1[0], g1[1]); w.w = cvt_pk_bf16(g1[2], g1[3]);
                *(u32x4*)rowp = w; }
    }
};
}

template <class F> __device__ __forceinline__ void prep_mat(bf16_t* dst, int NR, int K, int gtid, int gthreads, F src) {
    const int total = NR * (K >> 3);
    for (int i = gtid; i < total; i += gthreads) { const int n = i % NR, kb = i / NR; float v[8];
#pragma unroll
        for (int j = 0; j < 8; ++j) v[j] = src(n, kb * 8 + j);
        uint4 o; o.x = pg8::cvt_pk_bf16(v[0], v[1]); o.y = pg8::cvt_pk_bf16(v[2], v[3]); o.z = pg8::cvt_pk_bf16(v[4], v[5]); o.w = pg8::cvt_pk_bf16(v[6], v[7]);
        *(uint4*)(dst + (size_t)n * K + kb * 8) = o; }
}
template <class F, class R> __device__ __forceinline__ void prep_mat_rm(bf16_t* dst, int NR, int K, int gtid, int gthreads, F src, R rowmap) {
    const int total = NR * (K >> 3);
    for (int i = gtid; i < total; i += gthreads) { const int n = i % NR, kb = i / NR; float v[8];
#pragma unroll
        for (int j = 0; j < 8; ++j) v[j] = src(n, kb * 8 + j);
        uint4 o; o.x = pg8::cvt_pk_bf16(v[0], v[1]); o.y = pg8::cvt_pk_bf16(v[2], v[3]); o.z = pg8::cvt_pk_bf16(v[4], v[5]); o.w = pg8::cvt_pk_bf16(v[6], v[7]);
        *(uint4*)(dst + (size_t)rowmap(n) * K + kb * 8) = o; }
}
__device__ __forceinline__ void transpose_item(const float* W  , int ldw, bf16_t* WT  , int K, lfloat* scr, int lane) {
#pragma unroll 8
    for (int i = 0; i < 32; ++i) { const int kk = 2 * i + (lane >> 5); scr[kk * 33 + (lane & 31)] = W[(size_t)kk * ldw + (lane & 31)]; }
    asm volatile("s_waitcnt lgkmcnt(0)" ::: "memory");
    const int c = lane & 7;
#pragma unroll
    for (int jj = 0; jj < 4; ++jj) { const int n = (lane >> 3) + 8 * jj; const lfloat* p = scr + (8 * c) * 33 + n;
        uint4 o; o.x = pg8::cvt_pk_bf16(p[0], p[33]); o.y = pg8::cvt_pk_bf16(p[66], p[99]); o.z = pg8::cvt_pk_bf16(p[132], p[165]); o.w = pg8::cvt_pk_bf16(p[198], p[231]);
        *(uint4*)(WT + (size_t)n * K + 8 * c) = o; }
    asm volatile("s_waitcnt lgkmcnt(0)" ::: "memory");
}
__device__ __forceinline__ void phase_weights_tiled(CArgs* ap, int l, lfloat* lds) {
    const int tid = ltid(), lane = tid & 63, wave = tid >> 6; lfloat* scr = lds + wave * 2176;
    const int gw = lbid() * 8 + wave, ngw = gridDim.x * 8; unsigned char* ws = ap->ws;
    constexpr int I_IN = 16 * 96, I_O = 16 * 32, I_G = 16 * 88, I_D = 44 * 32, NIT = I_IN + I_O + 2 * I_G + I_D;
    for (int it = gw; it < NIT; it += ngw) { CArgs& a = *launder_args(ap); int r = it;
        if (r < I_IN) { const int kb = r / 96, nb = r % 96; transpose_item(a.in[6] + (size_t)l * DM * 3072 + (size_t)(kb * 64) * 3072 + nb * 32, 3072, (bf16_t*)(ws + OFF_WIN) + (size_t)(nb * 32) * DM + kb * 64, DM, scr, lane); continue; } r -= I_IN;
        if (r < I_O) { const int kb = r / 32, nb = r % 32; const int ks = (kb * 64 + 512) & 1023;
            transpose_item(a.in[7] + (size_t)l * DM * DM + (size_t)ks * DM + nb * 32, DM, (bf16_t*)(ws + OFF_WO) + (size_t)(nb * 32) * DM + kb * 64, DM, scr, lane); continue; } r -= I_O;
        if (r < 2 * I_G) { const int up = r >= I_G; if (up) r -= I_G; const int kb = r / 88, nb = r % 88, n0 = nb * 32; const int row0 = (n0 >> 7) * 256 + (n0 & 127) + (up ? 128 : 0);
            const float* W = (up ? a.in[32] : a.in[31]) + (size_t)l * DM * DFF;
            transpose_item(W + (size_t)(kb * 64) * DFF + n0, DFF, (bf16_t*)(ws + OFF_WGU) + (size_t)row0 * DM + kb * 64, DM, scr, lane); continue; } r -= 2 * I_G;
        { const int kb = r / 32, nb = r % 32; transpose_item(a.in[33] + (size_t)l * DFF * DM + (size_t)(kb * 64) * DM + nb * 32, DM, (bf16_t*)(ws + OFF_WD) + (size_t)(nb * 32) * DFF + kb * 64, DFF, scr, lane); }
    }
}
__device__ __forceinline__ void phase_weights(CArgs* ap, int l) {
    const int gtid = lbid() * 512 + ltid(), gth = gridDim.x * 512;
    unsigned char* ws = ap->ws;
    {   CArgs& a = *launder_args(ap);
        const float* mux = a.in[9] + (size_t)l * 3 * DM; const float* w1 = a.in[11] + (size_t)l * DM * 64; const float* a1 = a.in[14] + (size_t)l * DM * 64;
        const float* g1 = a.in[16] + (size_t)l * DM * 128; const float* muv = a.in[23]; const float* v1 = a.in[25]; const float* ga1 = a.in[27] + (size_t)l * DM * 16;
        prep_mat((bf16_t*)(ws + OFF_WIN) + (size_t)3072 * DM, 768, DM, gtid, gth, [=](int n, int k) -> float {
            if (n < 128) { const float mu = mux[k]; const int j = n & 63; return (n < 64 ? 1.f - mu : mu) * w1[k * 64 + j]; }
            if (n < 256) { const float mu = mux[DM + k]; const int j = n & 63; return (n < 192 ? 1.f - mu : mu) * a1[k * 64 + j]; }
            if (n < 512) { const float mu = mux[2 * DM + k]; const int j = n & 127; return (n < 384 ? 1.f - mu : mu) * g1[k * 128 + j]; }
            if (n < 576) { if (l == 0) return 0.f; const float mu = muv[k]; const int j = n & 31; return (n < 544 ? 1.f - mu : mu) * v1[k * 32 + j]; }
            if (n < 592) return ga1[k * 16 + (n - 576)];
            return 0.f; });
    }
    {   CArgs& a = *launder_args(ap);
        const float* w2 = a.in[12] + (size_t)l * 64 * 512; const float* a2 = a.in[15] + (size_t)l * 64 * 512; const float* g2 = a.in[17] + (size_t)l * 128 * 512;
        const float* v2 = a.in[26]; const float* ga2 = a.in[28] + (size_t)l * 16 * 128;
        prep_mat((bf16_t*)(ws + OFF_W2L), N2, K2, gtid, gth, [=](int n, int k) -> float {
            if (n < 512) return k < 64 ? w2[k * 512 + n] : 0.f;
            if (n < 1024) return (k >= 64 && k < 128) ? a2[(k - 64) * 512 + (n - 512)] : 0.f;
            if (n < 1536) return (k >= 128 && k < 256) ? g2[(k - 128) * 512 + (n - 1024)] : 0.f;
            if (n < 2048) return (l == 1 && k >= 256 && k < 288) ? v2[(k - 256) * 512 + (n - 1536)] : 0.f;
            if (n < 2176) return (k >= 288 && k < 304) ? ga2[(k - 288) * 128 + (n - 2048)] : 0.f;
            return 0.f; });
    }
}
__device__ __forceinline__ void phase_adaln(CArgs& a, lfloat* lds) {
    const int tid = ltid(); lfloat* sc = lds; lfloat* part = lds + 4096;
    for (int i = tid; i < 4096; i += 512) sc[i] = siluf_(a.in[1][i]);
    __syncthreads();
    float* mod = (float*)(a.ws + OFF_MOD);
    for (int item = lbid(); item < 2 * 192; item += gridDim.x) {
        const int l = item / 192, col0 = (item % 192) * 32, col = tid & 31, kg = tid >> 5;
        const float* W = a.in[2] + (size_t)l * DM * 6144 + col0 + col;
        float acc0 = 0.f, acc1 = 0.f, acc2 = 0.f, acc3 = 0.f;
#pragma unroll 8
        for (int kk = 0; kk < 64; ++kk) { const int k = kg * 64 + kk; const float w = W[(size_t)k * 6144];
            acc0 += sc[k] * w; acc1 += sc[1024 + k] * w; acc2 += sc[2048 + k] * w; acc3 += sc[3072 + k] * w; }
        part[(kg * 4 + 0) * 32 + col] = acc0; part[(kg * 4 + 1) * 32 + col] = acc1; part[(kg * 4 + 2) * 32 + col] = acc2; part[(kg * 4 + 3) * 32 + col] = acc3;
        __syncthreads();
        if (tid < 128) { const int b = tid >> 5; float s = a.in[3][l * 6144 + col0 + col];
#pragma unroll
            for (int g = 0; g < 16; ++g) s += part[(g * 4 + b) * 32 + col];
            mod[(l * 4 + b) * 6144 + col0 + col] = s; }
        __syncthreads();
    }
}
__device__ __forceinline__ void phase_modnorm(const float* X, const float* g, const float* mod  , int sh_off, bf16_t* out) {
    const int lane = ltid() & 63, gw = lbid() * 8 + (ltid() >> 6), ngw = gridDim.x * 8;
    for (int m = gw; m < MT; m += 2 * ngw) {
        const int m2 = m + ngw; const bool has2 = m2 < MT;
        const f32x4* xr = (const f32x4*)(X + (size_t)m * DM) + lane; const f32x4* xr2 = (const f32x4*)(X + (size_t)(has2 ? m2 : m) * DM) + lane;
        f32x4 v[4], u[4]; float s = 0.f, s2 = 0.f;
#pragma unroll
        for (int j = 0; j < 4; ++j) { v[j] = xr[64 * j]; u[j] = xr2[64 * j]; }
#pragma unroll
        for (int j = 0; j < 4; ++j) { s += sum4(v[j] * v[j]); s2 += sum4(u[j] * u[j]); }
        const float rstd = rsqrtf(wave_sum(s) * (1.f / DM) + 1e-6f), rstd2 = rsqrtf(wave_sum(s2) * (1.f / DM) + 1e-6f);
        const float* mp = mod + (m >> 12) * 6144 + sh_off; const float* mp2 = mod + ((has2 ? m2 : m) >> 12) * 6144 + sh_off;
        uint2* o = (uint2*)(out + (size_t)m * DM) + lane; uint2* o2 = (uint2*)(out + (size_t)(has2 ? m2 : m) * DM) + lane;
#pragma unroll
        for (int j = 0; j < 4; ++j) { const int c = 4 * lane + 256 * j; const f32x4 gg = *(const f32x4*)(g + c);
            o[64 * j] = pack4(v[j] * rstd * gg * (1.f + *(const f32x4*)(mp + 1024 + c)) + *(const f32x4*)(mp + c));
            if (has2) o2[64 * j] = pack4(u[j] * rstd2 * gg * (1.f + *(const f32x4*)(mp2 + 1024 + c)) + *(const f32x4*)(mp2 + c)); }
    }
}
__device__ __forceinline__ void phase_finalnorm(float* X, const float* g) {
    const int lane = ltid() & 63, gw = lbid() * 8 + (ltid() >> 6), ngw = gridDim.x * 8;
    for (int m = gw; m < MT; m += ngw) {
        f32x4* xr = (f32x4*)(X + (size_t)m * DM) + lane; f32x4 v[4]; float s = 0.f;
#pragma unroll
        for (int j = 0; j < 4; ++j) { v[j] = xr[64 * j]; s += sum4(v[j] * v[j]); }
        const float rstd = rsqrtf(wave_sum(s) * (1.f / DM) + 1e-6f);
#pragma unroll
        for (int j = 0; j < 4; ++j) { const int c = 4 * lane + 256 * j; xr[64 * j] = v[j] * rstd * *(const f32x4*)(g + c); }
    }
}
__device__ __forceinline__ void load8(const bf16_t* p, float (&v)[8]) { const uint4 u = *(const uint4*)p;
    v[0] = __uint_as_float(u.x << 16); v[1] = __uint_as_float(u.x & 0xffff0000u); v[2] = __uint_as_float(u.y << 16); v[3] = __uint_as_float(u.y & 0xffff0000u);
    v[4] = __uint_as_float(u.z << 16); v[5] = __uint_as_float(u.z & 0xffff0000u); v[6] = __uint_as_float(u.w << 16); v[7] = __uint_as_float(u.w & 0xffff0000u); }
__device__ __forceinline__ void store8(bf16_t* p, const float (&v)[8]) { uint4 o; o.x = pg8::cvt_pk_bf16(v[0], v[1]); o.y = pg8::cvt_pk_bf16(v[2], v[3]); o.z = pg8::cvt_pk_bf16(v[4], v[5]); o.w = pg8::cvt_pk_bf16(v[6], v[7]); *(uint4*)p = o; }
__device__ __forceinline__ void phase_loramid(const bf16_t* ZX, bf16_t* A2, const bf16_t* ZR, bf16_t* BND) {
    const int gtid = lbid() * 512 + ltid(), gth = gridDim.x * 512;
    for (int i = gtid; i < 1024 * 192; i += gth) { const int row = i / 192, q8 = (i % 192) * 8;
        *(uint4*)(BND + (size_t)row * 1536 + q8) = *(const uint4*)(ZR + (size_t)(row * 16 + 15) * 1536 + q8); }
    for (int i = gtid; i < MT * 48; i += gth) { const int m = i / 48, cg = i % 48, c = cg * 8, t = m & (SEQ - 1);
        const bf16_t* zr = ZX + (size_t)m * 768; float p[8], q[8], o[8];
        int pc, qc, mode;
        if (c < 64) { pc = c; qc = 64 + c; mode = 0; } else if (c < 128) { pc = 128 + (c - 64); qc = 192 + (c - 64); mode = 1; }
        else if (c < 256) { pc = 256 + (c - 128); qc = 384 + (c - 128); mode = 2; } else if (c < 288) { pc = 512 + (c - 256); qc = 544 + (c - 256); mode = 1; }
        else if (c < 304) { pc = 576 + (c - 288); qc = 0; mode = 3; } else { pc = 0; qc = 0; mode = 4; }
        if (mode == 4) {
#pragma unroll
            for (int j = 0; j < 8; ++j) o[j] = 0.f;
        } else {
            load8(zr + pc, p);
            if (mode != 3 && t > 0) load8(zr - 768 + qc, q); else {
#pragma unroll
                for (int j = 0; j < 8; ++j) q[j] = 0.f; }
#pragma unroll
            for (int j = 0; j < 8; ++j) { const float s = p[j] + q[j]; o[j] = mode == 0 ? tanhf_(s) : (mode == 2 ? sigmoidf_(s) : s); }
        }
        store8(A2 + (size_t)m * K2 + c, o); }
}
struct RwConst { f32x4 mu_r, mu_k, mu_v, k_k, k_a, w0, a0, v0; };
__device__ __forceinline__ RwConst rw_load_const(CArgs& a, int l, int c) {
    RwConst k; const float* mu = a.in[8] + (size_t)l * 3 * 512;
    k.mu_r = *(const f32x4*)(mu + c); k.mu_k = *(const f32x4*)(mu + 512 + c); k.mu_v = *(const f32x4*)(mu + 1024 + c);
    k.k_k = *(const f32x4*)(a.in[18] + l * 512 + c); k.k_a = *(const f32x4*)(a.in[19] + l * 512 + c);
    k.w0 = *(const f32x4*)(a.in[10] + l * 512 + c); k.a0 = *(const f32x4*)(a.in[13] + l * 512 + c);
    k.v0 = l ? *(const f32x4*)(a.in[24] + c) : (f32x4){0.f, 0.f, 0.f, 0.f};
    return k;
}
struct RwTok { uint2 r, k, v, wpre, apre, vgpre, vf; };
__device__ __forceinline__ RwTok rw_load_tok(const bf16_t* ZR, const bf16_t* PRE, const bf16_t* VF, int l, int m, int c) {
    RwTok x; const uint2 z = {0u, 0u};
    const uint2* zr = (const uint2*)(ZR + (size_t)m * 1536 + c); x.r = zr[0]; x.k = zr[128]; x.v = zr[256];
    const uint2* pr = (const uint2*)(PRE + (size_t)m * N2 + c); x.wpre = pr[0]; x.apre = pr[128];
    if (l) { x.vgpre = pr[384]; x.vf = *(const uint2*)(VF + (size_t)m * 512 + c); } else { x.vgpre = z; x.vf = z; }
    return x;
}
__device__ __forceinline__ void phase_rwkv_prep(CArgs& a, int l) {
    bf16_t* ZR = (bf16_t*)(a.ws + OFF_ZR); bf16_t* PRE = (bf16_t*)(a.ws + OFF_PRE); bf16_t* VF = (bf16_t*)(a.ws + OFF_VF); const bf16_t* BND = (const bf16_t*)(a.ws + OFF_BND);
    float* BON = (float*)(a.ws + OFF_BON); float* G16 = (float*)(a.ws + OFF_G16);
    const int g16 = (lbid() * 512 + ltid()) >> 4, ng16 = gridDim.x * 32, j = ltid() & 15;
    for (int g = g16; g < 8192; g += ng16) { const int hd = g & 7, run = g >> 3, c = hd * 64 + 4 * j, mbeg = run * 16;
        const RwConst k = rw_load_const(a, l, c); const f32x4 rk = *(const f32x4*)(a.in[20] + l * 512 + c);
        uint2 rp = {0u, 0u}, kp = rp, vp = rp;
        if (mbeg & (SEQ - 1)) { const uint2* bp = (const uint2*)(BND + (size_t)(run - 1) * 1536 + c); rp = bp[0]; kp = bp[128]; vp = bp[256]; }
        RwTok cur = rw_load_tok(ZR, PRE, VF, l, mbeg, c);
        f32x4 gam = {1.f, 1.f, 1.f, 1.f};
        for (int i = 0; i < 16; ++i) { const int m = mbeg + i;
            RwTok nxt = cur; if (i < 15) nxt = rw_load_tok(ZR, PRE, VF, l, m + 1, c);
            f32x4 r = unpack4(cur.r), kq = unpack4(cur.k), v = unpack4(cur.v);
            r = r + (unpack4(rp) - r) * k.mu_r; kq = kq + (unpack4(kp) - kq) * k.mu_k; v = v + (unpack4(vp) - v) * k.mu_v;
            const f32x4 apre = k.a0 + unpack4(cur.apre), wv = k.w0 + unpack4(cur.wpre); f32x4 av, w;
#pragma unroll
            for (int q = 0; q < 4; ++q) { av[q] = sigmoidf_(apre[q]); w[q] = __expf(-__expf(-softplusf_(-wv[q]) - 0.5f)); }
            const f32x4 kkv = kq * k.k_k; const float ss = row_allreduce16(sum4(kkv * kkv));
            const float inv = 1.f / fmaxf(sqrtf(ss), 1e-12f);
            const f32x4 kk = kkv * inv, kx = kq * (1.f + (av - 1.f) * k.k_a);
            if (l) { const f32x4 vg = k.v0 + unpack4(cur.vgpre), vf = unpack4(cur.vf);
#pragma unroll
                for (int q = 0; q < 4; ++q) v[q] = v[q] + (vf[q] - v[q]) * sigmoidf_(vg[q]); }
            const float bonus = row_allreduce16(sum4(r * kx * rk));
            const f32x4 khat = kk * gam; gam = gam * w;
            f32x4 ginv;
#pragma unroll
            for (int q = 0; q < 4; ++q) ginv[q] = 1.f / gam[q];
            uint2* zr = (uint2*)(ZR + (size_t)m * 1536 + c); uint2* pr = (uint2*)(PRE + (size_t)m * N2 + c);
            zr[0] = pack4(r * gam); zr[128] = pack4(kx * ginv); const uint2 vpk = pack4(v); zr[256] = vpk;
            pr[128] = pack4(khat); pr[384] = pack4(kk * av * ginv);
            if (l == 0) *(uint2*)(VF + (size_t)m * 512 + c) = vpk;
            if (j == 0) BON[(size_t)m * 8 + hd] = bonus;
            rp = cur.r; kp = cur.k; vp = cur.v; cur = nxt; }
        *(f32x4*)(G16 + ((size_t)run * 8 + hd) * 64 + 4 * j) = gam;
    }
}
constexpr int GL_BC = 0, GL_QA = 2048, GL_QB = GL_QA + 2112, GL_QC = GL_QB + 2112, GL_KA = GL_QC + 2112, GL_KB = GL_KA + 2112, GL_KT = GL_KB + 2112,
              GL_V = GL_KT + 2112, GL_SP = GL_V + 4096, GL_ATT = GL_SP + 2048, GL_END = GL_ATT + 64 * 65;
static_assert(GL_END * 4 <= 131072, "GLA/RET LDS");
__device__ __forceinline__ float ret_log2gamma(int h) { return __log2f(1.f - exp2f(-5.f - (float)h)); }
__device__ __forceinline__ void glaret_setup(CArgs& a, int l, int type, int b, int h, int c, lfloat* lds) {
    const int tid = ltid(); const int m0 = b * SEQ + c * 64;
    const bf16_t* ZG = (const bf16_t*)(a.ws + OFF_ZG); const bf16_t* PRE = (const bf16_t*)(a.ws + OFF_PRE);
    lfloat* bc = lds + GL_BC;
    if (type == 0) {
        { const int t = tid >> 3, d4 = (tid & 7) * 4; const f32x4 x = unpack4(*(const uint2*)(PRE + (size_t)(m0 + t) * N2 + 2048 + h * 32 + d4)) + *(const f32x4*)(a.in[29] + l * 128 + h * 32 + d4);
#pragma unroll
          for (int i = 0; i < 4; ++i) bc[t * 32 + d4 + i] = -softplusf_(-x[i]) * (1.f / 16.f); }
        __syncthreads();
        {
            lfloat* seg = lds + GL_ATT; const int d = tid & 31, sg = tid >> 5;
            float v0 = bc[(sg * 4 + 0) * 32 + d], v1 = v0 + bc[(sg * 4 + 1) * 32 + d], v2 = v1 + bc[(sg * 4 + 2) * 32 + d], v3 = v2 + bc[(sg * 4 + 3) * 32 + d];
            seg[sg * 32 + d] = v3;
            __syncthreads();
            float off = 0.f;
#pragma unroll
            for (int q = 0; q < 15; ++q) off += (q < sg) ? seg[q * 32 + d] : 0.f;
            bc[(sg * 4 + 0) * 32 + d] = v0 + off; bc[(sg * 4 + 1) * 32 + d] = v1 + off; bc[(sg * 4 + 2) * 32 + d] = v2 + off; bc[(sg * 4 + 3) * 32 + d] = v3 + off;
        }
        __syncthreads();
    }
    const float scl = 0.17677669529663687f;
    {
        const int t = tid >> 3, i0 = (tid & 7) * 2; const int qoff = type ? 768 : 0, koff = type ? 896 : 128;
        const bf16_t* zr = ZG + (size_t)(m0 + t) * 1536 + h * 32 + i0;
        const unsigned q1u = *(const unsigned*)(zr + qoff), q2u = *(const unsigned*)(zr + qoff + 16), k1u = *(const unsigned*)(zr + koff), k2u = *(const unsigned*)(zr + koff + 16);
        const float l2g = ret_log2gamma(h);
#pragma unroll
        for (int u = 0; u < 2; ++u) { const int i = i0 + u;
            const float q1 = u ? __uint_as_float(q1u & 0xffff0000u) : __uint_as_float(q1u << 16), q2 = u ? __uint_as_float(q2u & 0xffff0000u) : __uint_as_float(q2u << 16);
            const float k1 = u ? __uint_as_float(k1u & 0xffff0000u) : __uint_as_float(k1u << 16), k2 = u ? __uint_as_float(k2u & 0xffff0000u) : __uint_as_float(k2u << 16);
            const int o1 = t * 33 + i, o2 = t * 33 + i + 16;
            if (type == 0) {
                const float b1 = bc[t * 32 + i], b2 = bc[t * 32 + i + 16], e1 = bc[63 * 32 + i], e2 = bc[63 * 32 + i + 16];
                const float p1 = __expf(b1), m1 = __expf(-b1), p2 = __expf(b2), m2 = __expf(-b2);
                lds[GL_QA + o1] = q1 * scl * p1; lds[GL_QB + o1] = q1 * scl * m1; lds[GL_QC + o1] = q1 * scl * p1; lds[GL_KA + o1] = k1 * m1; lds[GL_KB + o1] = k1 * p1; lds[GL_KT + o1] = k1 * __expf(e1 - b1);
                lds[GL_QA + o2] = q2 * scl * p2; lds[GL_QB + o2] = q2 * scl * m2; lds[GL_QC + o2] = q2 * scl * p2; lds[GL_KA + o2] = k2 * m2; lds[GL_KB + o2] = k2 * p2; lds[GL_KT + o2] = k2 * __expf(e2 - b2);
            } else {
                const float invf = exp2f(-(float)i * 0.8304820237218406f);
                const float ang = (float)(c * 64 + t) * invf; const float nr = rintf(ang * 0.15915494309189535f);
                float rr = fmaf(-nr, 6.28125f, ang); rr = fmaf(-nr, 1.9353071795864769e-3f, rr);
                const float cs = __cosf(rr), sn = __sinf(rr);
                const float qr1 = q1 * cs - q2 * sn, qr2 = q2 * cs + q1 * sn, kr1 = k1 * cs - k2 * sn, kr2 = k2 * cs + k1 * sn;
                const float gq = exp2f(l2g * (float)(t + 1)), gk = exp2f(l2g * (float)(63 - t));
                lds[GL_QA + o1] = qr1 * scl; lds[GL_QB + o1] = qr1 * scl; lds[GL_QC + o1] = qr1 * scl * gq; lds[GL_KA + o1] = kr1; lds[GL_KB + o1] = kr1; lds[GL_KT + o1] = kr1 * gk;
                lds[GL_QA + o2] = qr2 * scl; lds[GL_QB + o2] = qr2 * scl; lds[GL_QC + o2] = qr2 * scl * gq; lds[GL_KA + o2] = kr2; lds[GL_KB + o2] = kr2; lds[GL_KT + o2] = kr2 * gk;
            } }
    }
    {
        const int t = tid >> 3, e8 = (tid & 7) * 8; float v[8]; load8(ZG + (size_t)(m0 + t) * 1536 + (type ? 1024 : 256) + h * 64 + e8, v);
#pragma unroll
        for (int i = 0; i < 8; ++i) lds[GL_V + t * 64 + e8 + i] = v[i];
    }
    __syncthreads();
}
__device__ __forceinline__ void phase_glaret_kv(CArgs& a, int l, lfloat* lds) {
    const int tid = ltid(); float* KV = (float*)(a.ws + OFF_KV); float* DEC = (float*)(a.ws + OFF_DEC);
    for (int uid = lbid(); uid < 2048; uid += gridDim.x) {
        const int type = uid >> 10, bh = (uid >> 6) & 15, c = uid & 63, b = bh >> 2, h = bh & 3;
        glaret_setup(a, l, type, b, h, c, lds);
        const int d = tid >> 4, e4 = (tid & 15) * 4; f32x4 acc = {0.f, 0.f, 0.f, 0.f};
#pragma unroll 8
        for (int t = 0; t < 64; ++t) acc += lds[GL_KT + t * 33 + d] * *(const LAS f32x4*)(lds + GL_V + t * 64 + e4);
        *(f32x4*)(KV + ((size_t)((type * 16 + bh) * 64 + c)) * 2048 + d * 64 + e4) = acc;
        if (type == 0 && tid < 32) DEC[(bh * 64 + c) * 32 + tid] = __expf(lds[GL_BC + 63 * 32 + tid]);
        __syncthreads();
    }
}
__device__ __forceinline__ void phase_glaret_out(CArgs& a, int l, lfloat* lds) {
    const int tid = ltid(); const float* KV = (const float*)(a.ws + OFF_KV);
    const bf16_t* ZG = (const bf16_t*)(a.ws + OFF_ZG); bf16_t* PRE = (bf16_t*)(a.ws + OFF_PRE);
    for (int uid = lbid(); uid < 2048; uid += gridDim.x) {
        const int type = uid >> 10, bh = (uid >> 6) & 15, c = uid & 63, b = bh >> 2, h = bh & 3; const int m0 = b * SEQ + c * 64;
        { const f32x4 s = *(const f32x4*)(KV + ((size_t)((type * 16 + bh) * 64 + c)) * 2048 + tid * 4); *(LAS f32x4*)(lds + GL_SP + tid * 4) = s; }
        glaret_setup(a, l, type, b, h, c, lds);
        const int n = tid >> 3, g8 = (tid & 7) * 8;
        {
            float acc[8];
#pragma unroll
            for (int i = 0; i < 8; ++i) acc[i] = 0.f;
            for (int d = 0; d < 32; ++d) { const float qa = lds[GL_QA + n * 33 + d], qb = lds[GL_QB + n * 33 + d];
#pragma unroll
                for (int i = 0; i < 8; ++i) { const int m = g8 + i; acc[i] += (m <= n) ? qa * lds[GL_KA + m * 33 + d] : qb * lds[GL_KB + m * 33 + d]; } }
            const float l2g = ret_log2gamma(h);
#pragma unroll
            for (int i = 0; i < 8; ++i) { const int m = g8 + i; const float pm = type ? exp2f(l2g * (float)(m > n ? m - n : n - m)) : 1.f; lds[GL_ATT + n * 65 + m] = acc[i] * pm; }
        }
        __syncthreads();
        f32x4 o0 = {0.f, 0.f, 0.f, 0.f}, o1 = {0.f, 0.f, 0.f, 0.f};
#pragma unroll 4
        for (int m = 0; m < 64; ++m) { const float w = lds[GL_ATT + n * 65 + m]; o0 += w * *(const LAS f32x4*)(lds + GL_V + m * 64 + g8); o1 += w * *(const LAS f32x4*)(lds + GL_V + m * 64 + g8 + 4); }
#pragma unroll 4
        for (int d = 0; d < 32; ++d) { const float w = lds[GL_QC + n * 33 + d]; o0 += w * *(const LAS f32x4*)(lds + GL_SP + d * 64 + g8); o1 += w * *(const LAS f32x4*)(lds + GL_SP + d * 64 + g8 + 4); }
        float s1 = sum4(o0) + sum4(o1); s1 += __shfl_xor(s1, 1); s1 += __shfl_xor(s1, 2); s1 += __shfl_xor(s1, 4);
        const float mean = type ? s1 * (1.f / 64.f) : 0.f;
        o0 = o0 - mean; o1 = o1 - mean;
        float s2 = sum4(o0 * o0) + sum4(o1 * o1); s2 += __shfl_xor(s2, 1); s2 += __shfl_xor(s2, 2); s2 += __shfl_xor(s2, 4);
        const float rs = rsqrtf(s2 * (1.f / 64.f) + 1e-6f);
        o0 = o0 * rs; o1 = o1 * rs;
        if (type == 0) { const float* lg = a.in[30] + l * 64 + g8; o0 = o0 * *(const f32x4*)lg; o1 = o1 * *(const f32x4*)(lg + 4); }
        float gt[8]; load8(ZG + (size_t)(m0 + n) * 1536 + (type ? 1280 : 512) + h * 64 + g8, gt);
        float ov[8];
#pragma unroll
        for (int i = 0; i < 4; ++i) { ov[i] = o0[i] * siluf_(gt[i]); ov[4 + i] = o1[i] * siluf_(gt[4 + i]); }
        store8(PRE + (size_t)(m0 + n) * N2 + type * 256 + h * 64 + g8, ov);
        __syncthreads();
    }
}
__device__ __forceinline__ void phase_rwkv_out(CArgs& a, int l) {
    const bf16_t* ZR = (const bf16_t*)(a.ws + OFF_ZR); bf16_t* PRE = (bf16_t*)(a.ws + OFF_PRE); const bf16_t* YS = (const bf16_t*)(a.ws + OFF_YS); const float* BON = (const float*)(a.ws + OFF_BON);
    const int g16 = (lbid() * 512 + ltid()) >> 4, ng16 = gridDim.x * 32, j = ltid() & 15;
    for (int it = g16; it < MT * 8; it += ng16) { const int m = it >> 3, hd = it & 7, c = hd * 64 + 4 * j;
        const f32x4 v = unpack4(*(const uint2*)(ZR + (size_t)m * 1536 + 1024 + c));
        const f32x4 g4 = unpack4(*(const uint2*)(PRE + (size_t)m * N2 + 1024 + c));
        const f32x4 y4 = unpack4(*(const uint2*)(YS + (size_t)m * 512 + c));
        const float bonus = BON[(size_t)m * 8 + hd];
        const float mean = row_allreduce16(sum4(y4)) * (1.f / 64.f); const f32x4 yc = y4 - mean;
        const float var = row_allreduce16(sum4(yc * yc)) * (1.f / 64.f); const float rs = rsqrtf(var + 64e-5f);
        const f32x4 lg = *(const f32x4*)(a.in[21] + l * 512 + c), lb = *(const f32x4*)(a.in[22] + l * 512 + c);
        const f32x4 res = (yc * rs * lg + lb + bonus * v) * g4;
        *(uint2*)(PRE + (size_t)m * N2 + 512 + c) = pack4(res);
    }
}
__device__ __forceinline__ void phase_scan(CArgs& a, int l, lfloat* lds, bool do_chunks) {
    const int tid = ltid(), bid = lbid();
    {
        const int gid = bid * 512 + tid;
        if (do_chunks && gid < 65536) { const int type = gid >> 15, r = gid & 32767, bh = r >> 11, elem = r & 2047, d = elem >> 6, h = bh & 3;
            float* base = (float*)(a.ws + OFF_KV) + ((size_t)((type * 16 + bh) * 64)) * 2048 + elem; const float* dec = (const float*)(a.ws + OFF_DEC) + (size_t)(bh * 64) * 32 + d;
            const float rdec = exp2f(ret_log2gamma(h) * 64.f); float s = 0.f;
            for (int c0 = 0; c0 < 64; c0 += 32) { float kv[32], dc[32];
#pragma unroll
                for (int u = 0; u < 32; ++u) { kv[u] = base[(size_t)(c0 + u) * 2048]; dc[u] = type ? rdec : dec[(c0 + u) * 32]; }
#pragma unroll
                for (int u = 0; u < 32; ++u) { base[(size_t)(c0 + u) * 2048] = s; s = s * dc[u] + kv[u]; } }
        }
    }
    const int bh = bid & 31, rg = bid >> 5, b = bh >> 3, hd = bh & 7, wave = tid >> 6, lane = tid & 63;
    const int m0 = b * SEQ;
    const bf16_t* ZR = (const bf16_t*)(a.ws + OFF_ZR); const bf16_t* PRE = (const bf16_t*)(a.ws + OFF_PRE); bf16_t* YS = (bf16_t*)(a.ws + OFF_YS); const float* G16 = (const float*)(a.ws + OFF_G16);
    constexpr int TB = 32, NBLK = SEQ / TB, REC = 20, STEP = 16 * REC, GOFF = TB * STEP, BUF = GOFF + 128, PBUF = TB * 64, POFF = 2 * BUF;
    static_assert((2 * BUF + 2 * PBUF) * 4 <= 131072, "scan LDS");
    const bool stager = wave >= 4, scanner = wave < 2; const int st = tid - 256, j = st & 15, c = hd * 64 + 4 * j, tok0 = st >> 4;
    struct StRaw { u32x2 r, kx, v, kk, b; f32x4 g; };
    StRaw ra, rb, sa, sb;
#define ST_LOAD(dst, m) do { const bf16_t* zr_ = ZR + (size_t)(m) * 1536 + c; const bf16_t* pr_ = PRE + (size_t)(m) * N2 + c; const float* gp_ = G16 + ((size_t)((m) >> 4) * 8 + hd) * 64 + 4 * j; \
        asm volatile("global_load_dwordx2 %0, %1, off" : "=v"(dst.r) : "v"(zr_) : "memory"); \
        asm volatile("global_load_dwordx2 %0, %1, off offset:1024" : "=v"(dst.kx) : "v"(zr_) : "memory"); \
        asm volatile("global_load_dwordx2 %0, %1, off offset:2048" : "=v"(dst.v) : "v"(zr_) : "memory"); \
        asm volatile("global_load_dwordx2 %0, %1, off offset:1024" : "=v"(dst.kk) : "v"(pr_) : "memory"); \
        asm volatile("global_load_dwordx2 %0, %1, off offset:3072" : "=v"(dst.b) : "v"(pr_) : "memory"); \
        asm volatile("global_load_dwordx4 %0, %1, off" : "=v"(dst.g) : "v"(gp_) : "memory"); } while (0)
#define ST_PIN(dst) asm volatile("" : "+v"(dst.r), "+v"(dst.kx), "+v"(dst.v), "+v"(dst.kk), "+v"(dst.b), "+v"(dst.g))
#define ST_PUT(src, tok, blk) do { lfloat* q_ = lds + ((blk) & 1) * BUF + (tok) * STEP + j * REC; \
        *(LAS f32x4*)(q_) = unpack4(src.kk); *(LAS f32x4*)(q_ + 4) = unpack4(src.b); *(LAS f32x4*)(q_ + 8) = unpack4(src.kx); *(LAS f32x4*)(q_ + 12) = unpack4(src.r); *(LAS f32x4*)(q_ + 16) = unpack4(src.v); \
        if (((tok) & 15) == 0) *(LAS f32x4*)(lds + ((blk) & 1) * BUF + GOFF + ((tok) >> 4) * 64 + 4 * j) = src.g; } while (0)
#define ST_REDUCE(blk) do { const int tt_ = st >> 3, w_ = (st >> 2) & 1, rl_ = st & 3; \
        const LAS unsigned short* p_ = (const LAS unsigned short*)(lds + POFF + ((blk) & 1) * PBUF) + tt_ * 128 + w_ * 64 + rl_ * 16; \
        const pg8::u32x4 a0_ = *(const LAS pg8::u32x4*)p_, a1_ = *(const LAS pg8::u32x4*)(p_ + 8); \
        float s_ = ((bf2f(a0_[0] & 0xffffu) + bf2f(a0_[0] >> 16)) + (bf2f(a0_[1] & 0xffffu) + bf2f(a0_[1] >> 16))) + ((bf2f(a0_[2] & 0xffffu) + bf2f(a0_[2] >> 16)) + (bf2f(a0_[3] & 0xffffu) + bf2f(a0_[3] >> 16))); \
        s_ += ((bf2f(a1_[0] & 0xffffu) + bf2f(a1_[0] >> 16)) + (bf2f(a1_[1] & 0xffffu) + bf2f(a1_[1] >> 16))) + ((bf2f(a1_[2] & 0xffffu) + bf2f(a1_[2] >> 16)) + (bf2f(a1_[3] & 0xffffu) + bf2f(a1_[3] >> 16))); \
        YS[(size_t)(m0 + (blk) * TB + tt_) * 512 + hd * 64 + rg * 8 + w_ * 4 + rl_] = f2bf1(s_); } while (0)
    if (stager) { ST_LOAD(ra, m0 + tok0); ST_LOAD(rb, m0 + tok0 + 16); asm volatile("s_waitcnt vmcnt(0)" ::: "memory"); ST_PIN(ra); ST_PIN(rb); ST_PUT(ra, tok0, 0); ST_PUT(rb, tok0 + 16, 0);
        ST_LOAD(ra, m0 + TB + tok0); ST_LOAD(rb, m0 + TB + tok0 + 16); ST_LOAD(sa, m0 + 2 * TB + tok0); ST_LOAD(sb, m0 + 2 * TB + tok0 + 16); }
    LDS_BARRIER();
    typedef float f32x2s __attribute__((ext_vector_type(2)));
    f32x2s Sl = {0.f, 0.f}, Sh = {0.f, 0.f};
    const int q = lane & 15, vrow = rg * 8 + (wave & 1) * 4 + (lane >> 4);
#define SCAN_BODY(i, XA, XB) do { \
        if (stager) { \
            if ((i) + 1 < NBLK) { if ((i) + 2 < NBLK) asm volatile("s_waitcnt vmcnt(12)" ::: "memory"); else asm volatile("s_waitcnt vmcnt(0)" ::: "memory"); ST_PIN(XA); ST_PIN(XB); ST_PUT(XA, tok0, (i) + 1); ST_PUT(XB, tok0 + 16, (i) + 1); }     \
            if ((i) > 0) ST_REDUCE((i) - 1); \
            if ((i) + 3 < NBLK) { const int t3_ = m0 + ((i) + 3) * TB + tok0; ST_LOAD(XA, t3_); ST_LOAD(XB, t3_ + 16); } \
        } else if (scanner) { \
            const lfloat* buf = lds + ((i) & 1) * BUF + q * REC; const lfloat* vb = lds + ((i) & 1) * BUF + (vrow >> 2) * REC + 16 + (vrow & 3); const lfloat* gb = lds + ((i) & 1) * BUF + GOFF + 4 * q; \
            LAS unsigned short* pp = (LAS unsigned short*)(lds + POFF + ((i) & 1) * PBUF) + (wave & 1) * 64 + lane; \
            f32x4 XK[4], XB_[4], XX[4], XR[4]; float VV[4]; \
            _Pragma("unroll") for (int t_ = 0; t_ < 3; ++t_) { const lfloat* p = buf + t_ * STEP; XK[t_] = *(const LAS f32x4*)p; XB_[t_] = *(const LAS f32x4*)(p + 4); XX[t_] = *(const LAS f32x4*)(p + 8); XR[t_] = *(const LAS f32x4*)(p + 12); VV[t_] = vb[t_ * STEP]; } \
            _Pragma("unroll") for (int tt = 0; tt < TB; ++tt) { \
                if (tt + 3 < TB) { const lfloat* p = buf + (tt + 3) * STEP; const int s_ = (tt + 3) & 3; XK[s_] = *(const LAS f32x4*)p; XB_[s_] = *(const LAS f32x4*)(p + 4); XX[s_] = *(const LAS f32x4*)(p + 8); XR[s_] = *(const LAS f32x4*)(p + 12); VV[s_] = vb[(tt + 3) * STEP]; } \
                const f32x4 kk = XK[tt & 3], bb = XB_[tt & 3], kx = XX[tt & 3], r = XR[tt & 3]; const float vv = VV[tt & 3]; \
                const f32x2s kl = {kk[0], kk[1]}, kh = {kk[2], kk[3]}, bl = {bb[0], bb[1]}, bh_ = {bb[2], bb[3]}, xl = {kx[0], kx[1]}, xh = {kx[2], kx[3]}, rl = {r[0], r[1]}, rh = {r[2], r[3]}; \
                const f32x2s d2 = __builtin_elementwise_fma(Sh, kh, Sl * kl); const float dk = row_allreduce16(d2[0] + d2[1]); \
                const f32x2s vv2 = {vv, vv}, nd2 = {-dk, -dk}; \
                Sl = __builtin_elementwise_fma(nd2, bl, __builtin_elementwise_fma(vv2, xl, Sl)); Sh = __builtin_elementwise_fma(nd2, bh_, __builtin_elementwise_fma(vv2, xh, Sh)); \
                const f32x2s y2 = __builtin_elementwise_fma(Sh, rh, Sl * rl); \
                pp[tt * 128] = (unsigned short)(__float_as_uint(y2[0] + y2[1]) >> 16);     \
                if ((tt & 15) == 15) { const f32x4 g_ = *(const LAS f32x4*)(gb + (tt >> 4) * 64); Sl = Sl * (f32x2s){g_[0], g_[1]}; Sh = Sh * (f32x2s){g_[2], g_[3]}; } }     \
        } \
        LDS_BARRIER(); } while (0)
    for (int i = 0; i < NBLK; i += 2) { SCAN_BODY(i, ra, rb); SCAN_BODY(i + 1, sa, sb); }
    if (stager) ST_REDUCE(NBLK - 1);
    asm volatile("s_waitcnt vmcnt(0)" ::: "memory");
#undef SCAN_BODY
#undef ST_REDUCE
#undef ST_LOAD
#undef ST_PIN
#undef ST_PUT
}
#define GAS __attribute__((address_space(1)))
constexpr size_t OFF_BAR = 512 * 1024, BAR_BYTES = 16384;
#define XB_TMO      128
#define XB_XCNT(j)  (256  + 64 * (j))
#define XB_XSUB(j)  (1280 + 64 * (j))
#define XB_XGEN(j)  (2304 + 64 * (j))
#define XB_TOP      3328
#define XB_TOPGEN   3392
#define XCD_BAR_WORDS 3456
#define XB_SPIN_CAP (1u << 18)

__device__ __forceinline__ unsigned xb_ld(unsigned* p)              { return __hip_atomic_load(p, __ATOMIC_RELAXED, __HIP_MEMORY_SCOPE_AGENT); }
__device__ __forceinline__ unsigned xb_add(unsigned* p, unsigned v) { return __hip_atomic_fetch_add(p, v, __ATOMIC_RELAXED, __HIP_MEMORY_SCOPE_AGENT); }
__device__ __forceinline__ unsigned xb_xcc_id() { return (unsigned)__builtin_amdgcn_s_getreg((3 << 11) | 20) & 0xFu; }
#define XB_SPIN(cond, bar) do { unsigned _sp = 0; while (cond) { __builtin_amdgcn_s_sleep(1); \
    if ((++_sp & 255u) == 0u) { if (xb_ld(&(bar)[XB_TMO])) break; if (_sp > XB_SPIN_CAP) { atomicAdd(&(bar)[XB_TMO], 1u); break; } } } } while (0)

struct XcdBarrier {
    unsigned* bar; unsigned x;
    volatile LAS unsigned* st;
};

__device__ __forceinline__ XcdBarrier xcd_barrier_post(unsigned* bar, volatile LAS unsigned* st) {
    XcdBarrier b; b.bar = bar; b.x = xb_xcc_id(); b.st = st;
    if (threadIdx.x == 0) (void)xb_add(&bar[XB_XCNT(b.x)], 1u);
    return b;
}
__device__ __forceinline__ void xcd_barrier_complete(unsigned* bar, unsigned x, unsigned& nloc, unsigned& nx) {
    const unsigned G = gridDim.x * gridDim.y * gridDim.z;
    unsigned sum, cnt, mine, sp = 0u;
    for (;;) {
        sum = 0u; cnt = 0u; mine = 0u;
#pragma unroll
        for (unsigned j = 0; j < 16; ++j) { const unsigned c = xb_ld(&bar[XB_XCNT(j)]); sum += c; cnt += (c > 0u) ? 1u : 0u; mine = (j == x) ? c : mine; }
        if (sum == G) break;
        __builtin_amdgcn_s_sleep(1);
        if ((++sp & 255u) == 0u) { if (xb_ld(&bar[XB_TMO])) break; if (sp > XB_SPIN_CAP) { atomicAdd(&bar[XB_TMO], 1u); break; } }
    }
    nloc = mine > 0u ? mine : 1u; nx = cnt > 0u ? cnt : 1u;
}

__device__ __forceinline__ void xcd_barrier(const XcdBarrier& b) {
    asm volatile("s_waitcnt vmcnt(0)" ::: "memory");
    __syncthreads();
    if (threadIdx.x == 0) {
        unsigned* bar = b.bar;
        __builtin_amdgcn_s_waitcnt(0);
        unsigned nloc = b.st[0], nx = b.st[1];
        if (nloc == 0u) { xcd_barrier_complete(bar, b.x, nloc, nx); b.st[0] = nloc; b.st[1] = nx; }
        const unsigned old = xb_add(&bar[XB_XSUB(b.x)], 1u);
        const unsigned gen = old / nloc;
        if (old + 1u == (gen + 1u) * nloc) {
            __builtin_amdgcn_fence(__ATOMIC_RELEASE, "agent");
            asm volatile("s_waitcnt vmcnt(0)" ::: "memory");
            const unsigned og = xb_add(&bar[XB_TOP], 1u);
            const unsigned tg = og / nx;
            if (og + 1u == (tg + 1u) * nx) xb_add(&bar[XB_TOPGEN], 1u);
            else XB_SPIN(xb_ld(&bar[XB_TOPGEN]) == tg, bar);
            __builtin_amdgcn_fence(__ATOMIC_ACQUIRE, "agent");
            xb_add(&bar[XB_XGEN(b.x)], 1u);
            asm volatile("s_waitcnt vmcnt(0)" ::: "memory");
        } else {
            XB_SPIN(xb_ld(&bar[XB_XGEN(b.x)]) == gen, bar);
            __builtin_amdgcn_fence(__ATOMIC_ACQUIRE, "agent");
            asm volatile("s_waitcnt vmcnt(0)" ::: "memory");
        }
    }
    __syncthreads();
}

__global__ void __launch_bounds__(512, 2) mega_fwd(Args a_unused) {
    CArgs* ap0 = (CArgs*)__builtin_amdgcn_kernarg_segment_ptr();
    extern __shared__ __attribute__((aligned(16))) unsigned char lds_raw[];
    LAS unsigned char* ldsb = (LAS unsigned char*)lds_raw; lfloat* ldsf = (lfloat*)lds_raw;
    cg::grid_group grid = cg::this_grid();
    const int ph_lo = ap0->ph_lo, ph_hi = ap0->ph_hi, coop = ap0->coop;
    volatile LAS unsigned* MISC = (volatile LAS unsigned*)(ldsb + 131072);
    if (threadIdx.x < 16) MISC[threadIdx.x] = 0u;
    __syncthreads();
    const XcdBarrier xbar = xcd_barrier_post((unsigned*)(ap0->ws + OFF_BAR), MISC + 8);
    for (int ph = ph_lo; ph < ph_hi; ++ph) {
        const int l = ph / NPH, k = ph % NPH;
        const int nrep = (ph < NL * NPH && ((DUPMASK >> k) & 1)) ? 2 : 1;
        for (int rep = 0; rep < nrep; ++rep) {
        if (rep) { if (coop == 2) grid.sync(); else if (coop) xcd_barrier(xbar); }
        CArgs* ap = launder_args(ap0); CArgs& a = *ap;
        unsigned char* ws = a.ws; const int G = gridDim.x, bx = lbid();
        float* MOD = (float*)(ws + OFF_MOD);
        bf16_t* XN = (bf16_t*)(ws + OFF_XN); bf16_t* ZR = (bf16_t*)(ws + OFF_ZR); bf16_t* ZG = (bf16_t*)(ws + OFF_ZG); bf16_t* ZX = (bf16_t*)(ws + OFF_ZX);
        bf16_t* PRE = (bf16_t*)(ws + OFF_PRE); bf16_t* HFF = (bf16_t*)(ws + OFF_HFF);
        const float* mod = MOD + l * 4 * 6144;
        if (ph == NL * NPH) { phase_finalnorm(a.out, a.in[34]); }
        else if (k == 0 && (PHMASK & 1)) { if (l == 0) phase_adaln(a, ldsf); phase_weights(ap, l); __syncthreads(); phase_weights_tiled(ap, l, ldsf); }
        else if (k == 1 && (PHMASK >> 1 & 1)) { phase_modnorm(l == 0 ? a.in[0] : a.out, a.in[4] + l * DM, mod, 0, XN); }
        else if (k == 2 && (PHMASK >> 2 & 1)) { pg8::Gemm g{XN, (const bf16_t*)(ws + OFF_WIN), MT, NIN, DM, DM}; pg8::StaticOrder S; S.init(MT, NIN, G, bx); pg8::EpiIn E{ZR, ZG, ZX};
            pg8::gemm_phase<pg8::EpiIn, pg8::StaticOrder, true, true>(ldsb, g, S, E); }
        else if (k == 3 && (PHMASK >> 3 & 1)) { phase_loramid(ZX, XN, ZR, (bf16_t*)(ws + OFF_BND)); }
        else if (k == 4 && (PHMASK >> 4 & 1)) { pg8::Gemm g{XN, (const bf16_t*)(ws + OFF_W2L), MT, N2, K2, K2}; pg8::StaticOrder S; S.init(MT, N2, G, bx); pg8::EpiPlain E{PRE, N2};
            pg8::gemm_phase<pg8::EpiPlain, pg8::StaticOrder, true, true>(ldsb, g, S, E); }
        else if (k == 5 && (PHMASK >> 5 & 1)) { phase_rwkv_prep(a, l); phase_glaret_kv(a, l, ldsf); }
        else if (k == 6 && (PHMASK >> 6 & 1)) { phase_scan(a, l, ldsf, rep == 0); }
        else if (k == 7 && (PHMASK >> 7 & 1)) { phase_rwkv_out(a, l); phase_glaret_out(a, l, ldsf); }
        else if (k == 8 && (PHMASK >> 8 & 1)) { pg8::Gemm g{PRE, (const bf16_t*)(ws + OFF_WO), MT, DM, DM, N2}; pg8::StaticOrder S; S.init(MT, DM, G, bx); pg8::EpiRes E{l == 0 ? a.in[0] : a.out, a.out, mod + 2048};
            pg8::gemm_phase<pg8::EpiRes, pg8::StaticOrder, true, true>(ldsb, g, S, E); }
        else if (k == 9 && (PHMASK >> 9 & 1)) { phase_modnorm(a.out, a.in[5] + l * DM, mod, 3072, XN); }
        else if (k == 10 && (PHMASK >> 10 & 1)) { pg8::Gemm g{XN, (const bf16_t*)(ws + OFF_WGU), MT, NGU, DM, DM}; pg8::StaticOrder S; S.init(MT, NGU, G, bx); pg8::EpiSwiGLU E{HFF};
            pg8::gemm_phase<pg8::EpiSwiGLU, pg8::StaticOrder, true, true>(ldsb, g, S, E); }
        else if (PHMASK >> 11 & 1) { pg8::Gemm g{HFF, (const bf16_t*)(ws + OFF_WD), MT, DM, DFF, DFF}; pg8::StaticOrder S; S.init(MT, DM, G, bx); pg8::EpiRes E{a.out, a.out, mod + 5120};
            pg8::gemm_phase<pg8::EpiRes, pg8::StaticOrder, true, true>(ldsb, g, S, E); }
        }
        if (ph + 1 < ph_hi) { if (coop == 2) grid.sync(); else if (coop) { xcd_barrier(xbar); for (int xs = 0; xs < EXTRA_SYNCS; ++xs) xcd_barrier(xbar); } }
    }
}

constexpr int LDS_BYTES = 147456;
extern "C" void kernel_launch(void* const* d_in, const int* in_sizes, int n_in, void* d_out, int out_size, void* d_ws, size_t ws_size, hipStream_t stream) {
    static int grid = 0;
    if (grid == 0) {
        if (n_in != 35 || out_size != MT * DM || ws_size < OFF_END) { fprintf(stderr, "kernel_launch: unexpected problem (n_in %d out %d ws %zu)\n", n_in, out_size, ws_size); grid = -1; return; }
        int dev = 0, cus = 0, per_cu = 0;
        hipGetDevice(&dev); hipDeviceGetAttribute(&cus, hipDeviceAttributeMultiprocessorCount, dev);
        hipFuncSetAttribute((const void*)mega_fwd, hipFuncAttributeMaxDynamicSharedMemorySize, LDS_BYTES);
        hipOccupancyMaxActiveBlocksPerMultiprocessor(&per_cu, (const void*)mega_fwd, 512, LDS_BYTES);
        if (per_cu < 1) { fprintf(stderr, "kernel_launch: occupancy query says %d blocks per CU\n", per_cu); per_cu = 1; }
        (void)hipGetLastError();
        grid = cus;
    }
    if (grid < 0) return;
    Args a{};
    for (int i = 0; i < 35; ++i) a.in[i] = (const float*)d_in[i];
    a.out = (float*)d_out; a.ws = (unsigned char*)d_ws;
#if MK_MULTI
    for (int ph = 0; ph <= NL * NPH; ++ph) { a.ph_lo = ph; a.ph_hi = ph + 1; a.coop = 0; hipLaunchKernelGGL(mega_fwd, dim3(grid), dim3(512), LDS_BYTES, stream, a); }
#else
    a.ph_lo = 0; a.ph_hi = NL * NPH + 1; a.coop = 1;
    if (hipMemsetAsync((unsigned char*)d_ws + OFF_BAR, 0, BAR_BYTES, stream) != hipSuccess) { fprintf(stderr, "memset failed\n"); return; }
    void* args[] = {&a};
    hipError_t e = hipLaunchCooperativeKernel((const void*)mega_fwd, dim3(grid), dim3(512), args, LDS_BYTES, stream);
    if (e != hipSuccess) fprintf(stderr, "cooperative launch failed: %s (grid %d)\n", hipGetErrorString(e), grid);
#endif
}
```
